# Optimizing an MI355X kernel written in HIP

```python
import math
import jax, jax.numpy as jnp
from jax import lax
import numpy as np

D_MODEL = 1024
BATCH = 8
SEQ = 4096
DEPTH = 2

CHUNK = 64
Q_BLOCK = 128
HEAD_DIM = 64
H_DIFF = 4
H_FOX = 6
H_CHUNK = 6
N_PREV_CHUNKS = 8
REL_CLIP = 128
D_FF = 2816
CONV_WIDTH = 3
PLE_DIM = 256
EPS = 1e-6
NEG_INF = -1e30

W_DIFF = H_DIFF * HEAD_DIM
W_FOX = H_FOX * HEAD_DIM
W_CHUNK = H_CHUNK * HEAD_DIM
MIX_WIDTH = W_DIFF + W_FOX + W_CHUNK
IN_SIZES = (W_DIFF,) * 5 + (W_FOX,) * 3 + (H_FOX,) + (W_CHUNK,) * 3
IN_COLS = sum(IN_SIZES)
IN_SPLITS = tuple(int(c) for c in np.cumsum(IN_SIZES)[:-1])
ALIBI_SLOPES = tuple(2.0 ** (-8.0 * (h + 1) / H_DIFF) for h in range(H_DIFF))

kernel_name = "hymba_style_chunk_causal_hybrid_block"


def rms_norm(x, g):
    xf = x.astype(jnp.float32)
    y = xf * lax.rsqrt(jnp.mean(xf * xf, axis=-1, keepdims=True) + EPS)
    return (y * g.astype(jnp.float32)).astype(x.dtype)


def split_heads(t, n_heads):
    return t.reshape(t.shape[0], t.shape[1], n_heads, HEAD_DIM)


def query_blocks(q):
    b, s = q.shape[0], q.shape[1]
    q = q.reshape((b, s // Q_BLOCK, Q_BLOCK) + q.shape[2:])
    return jnp.swapaxes(q, 0, 1)


def merge_blocks(o):
    nb, b, qb, h, d = o.shape
    return jnp.swapaxes(o, 0, 1).reshape(b, nb * qb, h * d)


def diff_attention(q1, q2, k1, k2, v, lam, subln_g, lam_init):
    S = k1.shape[1]
    slopes = jnp.asarray(ALIBI_SLOPES, jnp.float32)
    kpos = jnp.arange(S)
    scale = HEAD_DIM ** -0.5

    def block(args):
        q1b, q2b, blk = args
        qpos = blk * Q_BLOCK + jnp.arange(Q_BLOCK)
        dist = jnp.abs(qpos[:, None] - kpos[None, :]).astype(jnp.float32)
        bias = -slopes[:, None, None] * dist
        allowed = (kpos[None, :] // CHUNK) <= (qpos[:, None] // CHUNK)

        def probs(qb, k):
            s = jnp.einsum('bqhd,bkhd->bhqk', qb, k).astype(jnp.float32) * scale + bias
            s = jnp.where(allowed, s, NEG_INF)
            return jax.nn.softmax(s, axis=-1)

        a = probs(q1b, k1) - lam * probs(q2b, k2)
        return jnp.einsum('bhqk,bkhd->bqhd', a.astype(v.dtype), v)

    nb = S // Q_BLOCK
    o = lax.map(block, (query_blocks(q1), query_blocks(q2), jnp.arange(nb)))
    o = rms_norm(o, subln_g) * (1.0 - lam_init)
    return merge_blocks(o)


def forgetting_attention(q, k, v, log_f):
    B, S, H, _ = q.shape
    F = jnp.cumsum(log_f, axis=1)
    F_k = jnp.transpose(F, (0, 2, 1))
    F_q = jnp.transpose(query_blocks(F), (0, 1, 3, 2))
    kpos = jnp.arange(S)
    scale = HEAD_DIM ** -0.5

    def block(args):
        qb, fq, blk = args
        qpos = blk * Q_BLOCK + jnp.arange(Q_BLOCK)
        s = jnp.einsum('bqhd,bkhd->bhqk', qb, k).astype(jnp.float32) * scale
        s = s + fq[..., None] - F_k[:, :, None, :]
        allowed = kpos[None, :] <= qpos[:, None]
        s = jnp.where(allowed, s, NEG_INF)
        pr = jax.nn.softmax(s, axis=-1)
        return jnp.einsum('bhqk,bkhd->bqhd', pr.astype(v.dtype), v)

    nb = S // Q_BLOCK
    o = lax.map(block, (query_blocks(q), F_q, jnp.arange(nb)))
    return merge_blocks(o)


def chunk_band(t):
    b, s, h, d = t.shape
    nc = s // CHUNK
    tc = t.reshape(b, nc, CHUNK, h, d)
    tp = jnp.pad(tc, ((0, 0), (N_PREV_CHUNKS, 0), (0, 0), (0, 0), (0, 0)))
    return jnp.concatenate([tp[:, j:j + nc] for j in range(N_PREV_CHUNKS + 1)], axis=2)


def chunk_attention(q, k, v, rel_table):
    B, S, H, d = q.shape
    nc = S // CHUNK
    band_len = (N_PREV_CHUNKS + 1) * CHUNK
    qc = q.reshape(B, nc, CHUNK, H, d)
    kb = chunk_band(k)
    vb = chunk_band(v)
    qq = np.arange(CHUNK)[:, None]
    kk = np.arange(band_len)[None, :]
    rel = N_PREV_CHUNKS * CHUNK + qq - kk
    idx = np.clip(rel, -REL_CLIP, REL_CLIP) + REL_CLIP
    bias = rel_table[:, idx].astype(jnp.float32)
    key_chunk = (jnp.arange(nc)[:, None] - N_PREV_CHUNKS
                 + (jnp.arange(band_len) // CHUNK)[None, :])
    valid = (key_chunk >= 0)[:, None, None, :]
    s = jnp.einsum('bcqhd,bckhd->bchqk', qc, kb).astype(jnp.float32) * (HEAD_DIM ** -0.5) + bias
    s = jnp.where(valid, s, NEG_INF)
    pr = jax.nn.softmax(s, axis=-1)
    o = jnp.einsum('bchqk,bckhd->bcqhd', pr.astype(v.dtype), vb)
    return o.reshape(B, S, H * d)


def conv_gated_mlp(h, w_up, conv_w, conv_b, w_down):
    u = h @ w_up
    S = u.shape[1]
    up = jnp.pad(u, ((0, 0), (CONV_WIDTH - 1, 0), (0, 0)))
    c = conv_b
    for j in range(CONV_WIDTH):
        c = c + conv_w[j] * up[:, j:j + S]
    gate, val = jnp.split(c, 2, axis=-1)
    return (jax.nn.silu(gate) * val) @ w_down


def setup_inputs(seed: int = 0) -> dict:
    key = jax.random.key(seed)
    ks = jax.random.split(key, 20)
    f32 = jnp.float32
    nrm = lambda k, shape, s: jax.random.normal(k, shape, f32) * s
    gain = lambda k, shape: 1.0 + 0.05 * jax.random.normal(k, shape, f32)
    return {
        "x": jax.random.normal(ks[0], (BATCH, SEQ, D_MODEL), f32),
        "p": jax.random.normal(ks[1], (DEPTH, BATCH, SEQ, PLE_DIM), f32),
        "ln_mix": gain(ks[2], (DEPTH, D_MODEL)),
        "w_in": nrm(ks[3], (DEPTH, D_MODEL, IN_COLS), D_MODEL ** -0.5),
        "qk_gain": gain(ks[4], (DEPTH, 6, HEAD_DIM)),
        "lam_params": nrm(ks[5], (DEPTH, 4, HEAD_DIM), 0.1),
        "subln_gain": gain(ks[6], (DEPTH, HEAD_DIM)),
        "fgate_bias": jax.random.uniform(ks[7], (DEPTH, H_FOX), f32, 1.0, 4.0),
        "rel_bias": nrm(ks[8], (DEPTH, H_CHUNK, 2 * REL_CLIP + 1), 0.1),
        "w_out": nrm(ks[9], (DEPTH, MIX_WIDTH, D_MODEL), MIX_WIDTH ** -0.5),
        "ln_ffn": gain(ks[10], (DEPTH, D_MODEL)),
        "w_up": nrm(ks[11], (DEPTH, D_MODEL, 2 * D_FF), D_MODEL ** -0.5),
        "conv_w": nrm(ks[12], (DEPTH, CONV_WIDTH, 2 * D_FF), CONV_WIDTH ** -0.5),
        "conv_b": nrm(ks[13], (DEPTH, 2 * D_FF), 0.02),
        "w_down": nrm(ks[14], (DEPTH, D_FF, D_MODEL), D_FF ** -0.5),
        "ln_ple": gain(ks[15], (DEPTH, D_MODEL)),
        "w_ple_gate": nrm(ks[16], (DEPTH, D_MODEL, D_MODEL), D_MODEL ** -0.5),
        "w_ple_proj": nrm(ks[17], (DEPTH, PLE_DIM, D_MODEL), PLE_DIM ** -0.5),
    }


def reference(x, p, ln_mix, w_in, qk_gain, lam_params, subln_gain, fgate_bias, rel_bias,
              w_out, ln_ffn, w_up, conv_w, conv_b, w_down, ln_ple, w_ple_gate, w_ple_proj):
    h = x
    for i in range(DEPTH):
        hn = rms_norm(h, ln_mix[i])
        z = hn @ w_in[i]
        (q1, q2, k1, k2, va, qf, kf, vf, fg, qc, kc, vc) = jnp.split(z, IN_SPLITS, axis=-1)
        g = qk_gain[i]
        q1 = rms_norm(split_heads(q1, H_DIFF), g[0])
        q2 = rms_norm(split_heads(q2, H_DIFF), g[0])
        k1 = rms_norm(split_heads(k1, H_DIFF), g[1])
        k2 = rms_norm(split_heads(k2, H_DIFF), g[1])
        va = split_heads(va, H_DIFF)
        lp = lam_params[i].astype(jnp.float32)
        lam_init = 0.8 - 0.6 * math.exp(-0.3 * i)
        lam = jnp.exp(jnp.sum(lp[0] * lp[1])) - jnp.exp(jnp.sum(lp[2] * lp[3])) + lam_init
        o_a = diff_attention(q1, q2, k1, k2, va, lam, subln_gain[i], lam_init)
        qf = rms_norm(split_heads(qf, H_FOX), g[2])
        kf = rms_norm(split_heads(kf, H_FOX), g[3])
        vf = split_heads(vf, H_FOX)
        log_f = jax.nn.log_sigmoid(fg.astype(jnp.float32) + fgate_bias[i].astype(jnp.float32))
        o_b = forgetting_attention(qf, kf, vf, log_f)
        qc = rms_norm(split_heads(qc, H_CHUNK), g[4])
        kc = rms_norm(split_heads(kc, H_CHUNK), g[5])
        vc = split_heads(vc, H_CHUNK)
        o_c = chunk_attention(qc, kc, vc, rel_bias[i])
        h = h + jnp.concatenate([o_a, o_b, o_c], axis=-1) @ w_out[i]
        h = h + conv_gated_mlp(rms_norm(h, ln_ffn[i]), w_up[i], conv_w[i], conv_b[i], w_down[i])
        gate = jax.nn.sigmoid(rms_norm(h, ln_ple[i]) @ w_ple_gate[i])
        h = h + (p[i] @ w_ple_proj[i]) * gate
    return h
```

```cpp
#include <hip/hip_runtime.h>
#include <hip/hip_cooperative_groups.h>
#include <cstdio>
#include <cstdint>
namespace cg = cooperative_groups;

#define LAS __attribute__((address_space(3)))
typedef unsigned short bf16_t;
typedef short bf16x8 __attribute__((ext_vector_type(8)));
typedef short s16x4 __attribute__((ext_vector_type(4)));
typedef float f32x4 __attribute__((ext_vector_type(4)));
typedef float f32x16 __attribute__((ext_vector_type(16)));
typedef unsigned u32x4 __attribute__((ext_vector_type(4)));
typedef unsigned u32x2 __attribute__((ext_vector_type(2)));
typedef float f32x2_t __attribute__((ext_vector_type(2)));
typedef __bf16 bf16x2_t __attribute__((ext_vector_type(2)));

constexpr int NB = 8, SEQ = 4096, T = NB * SEQ, DM = 1024, ZP = 3584, DFF = 2816, UPN = 5632, PLED = 256, INC = 3590;
constexpr float EPS = 1e-6f, LOG2E = 1.4426950408889634f, C2 = 0.125f * 1.4426950408889634f;

constexpr size_t WS_CTL = 0;
constexpr size_t SZ_WIN = (size_t)ZP * DM * 2, SZ_WOUT = (size_t)DM * DM * 2, SZ_WUP = (size_t)UPN * DM * 2, SZ_WDN = (size_t)DM * DFF * 2, SZ_WGT = (size_t)DM * DM * 2, SZ_WPJ = (size_t)DM * PLED * 2;
constexpr size_t SZ_PB = (size_t)T * PLED * 2, SZ_HN = (size_t)T * DM * 2, SZ_Z = (size_t)T * ZP * 2, SZ_LOGF = (size_t)T * 6 * 4, SZ_EDGE = (size_t)128 * 22 * 1024 * 4;
constexpr size_t WS_WIN = 16384;
constexpr int CTL_Q = 3584;
constexpr size_t WS_WOUT = WS_WIN + 2 * SZ_WIN;
constexpr size_t WS_WUP = WS_WOUT + 2 * SZ_WOUT;
constexpr size_t WS_WDN = WS_WUP + 2 * SZ_WUP;
constexpr size_t WS_WGT = WS_WDN + 2 * SZ_WDN;
constexpr size_t WS_WPJ = WS_WGT + 2 * SZ_WGT;
constexpr size_t WS_PB = WS_WPJ + 2 * SZ_WPJ;
constexpr size_t WS_HN = WS_PB + 2 * SZ_PB;
constexpr size_t WS_Z = WS_HN + SZ_HN;
constexpr size_t WS_LOGF = WS_Z + SZ_Z;
constexpr size_t WS_F2 = WS_LOGF + SZ_LOGF;
constexpr size_t WS_EDGE = WS_F2 + SZ_LOGF;
constexpr size_t WS_HB = WS_EDGE + SZ_EDGE;
constexpr size_t WS_RSQ = WS_HB + SZ_HN;
constexpr size_t SZ_RSQ = (size_t)4 * T * 8;
constexpr size_t WS_END = WS_RSQ + SZ_RSQ;

__device__ __forceinline__ unsigned pk2(float lo, float hi) { f32x2_t v = {lo, hi}; bf16x2_t b = __builtin_convertvector(v, bf16x2_t); return __builtin_bit_cast(unsigned, b); }
#define DPPF(v, ctrl) __builtin_bit_cast(float, __builtin_amdgcn_update_dpp(0, __builtin_bit_cast(int, (v)), (ctrl), 0xf, 0xf, false))
__device__ __forceinline__ float xor16_sum(float v) { const auto r = __builtin_amdgcn_permlane16_swap(__float_as_uint(v), __float_as_uint(v), false, false); return __uint_as_float(r[0]) + __uint_as_float(r[1]); }
__device__ __forceinline__ float xor32_sum(float v) { const auto r = __builtin_amdgcn_permlane32_swap(__float_as_uint(v), __float_as_uint(v), false, false); return __uint_as_float(r[0]) + __uint_as_float(r[1]); }
__device__ __forceinline__ float xor16_max(float v) { const auto r = __builtin_amdgcn_permlane16_swap(__float_as_uint(v), __float_as_uint(v), false, false); return fmaxf(__uint_as_float(r[0]), __uint_as_float(r[1])); }
__device__ __forceinline__ float xor32_max(float v) { const auto r = __builtin_amdgcn_permlane32_swap(__float_as_uint(v), __float_as_uint(v), false, false); return fmaxf(__uint_as_float(r[0]), __uint_as_float(r[1])); }
__device__ __forceinline__ float row16_sum(float v) { v += DPPF(v, 0xB1); v += DPPF(v, 0x4E); v += DPPF(v, 0x141); v += DPPF(v, 0x140); return v; }
__device__ __forceinline__ float wave_sum(float v) { return xor32_sum(xor16_sum(row16_sum(v))); }
__device__ __forceinline__ float wave_max(float v) {
    v = fmaxf(v, DPPF(v, 0xB1)); v = fmaxf(v, DPPF(v, 0x4E)); v = fmaxf(v, DPPF(v, 0x141)); v = fmaxf(v, DPPF(v, 0x140));
    return xor32_max(xor16_max(v));
}
__device__ __forceinline__ float fast_exp2(float x) { return __builtin_amdgcn_exp2f(x); }
__device__ __forceinline__ float fast_rcp(float x) { return __builtin_amdgcn_rcpf(x); }
__device__ __forceinline__ float fast_rsq(float x) { return __builtin_amdgcn_rsqf(x); }
typedef unsigned long long u64_t;
__device__ __forceinline__ float rsq_sum(const u64_t* rsq, int row) { return (float)rsq[row] * (1.0f / 16777216.0f); }
__device__ __forceinline__ float row_rstd(const u64_t* rsq, int row) { return fast_rsq(rsq_sum(rsq, row) * (1.0f / DM) + EPS); }
__device__ __forceinline__ float sigmoidf_(float v) { return fast_rcp(1.0f + fast_exp2(-v * LOG2E)); }
#define XB_TMO      128
#define XB_XCNT(j)  (256  + 64 * (j))
#define XB_XSUB(j)  (1280 + 64 * (j))
#define XB_XGEN(j)  (2304 + 64 * (j))
#define XB_TOP      3328
#define XB_TOPGEN   3392
#define XCD_BAR_WORDS 3456
#define XB_SPIN_CAP (1u << 18)
__device__ __forceinline__ unsigned xb_ld(unsigned* p)              { return __hip_atomic_load(p, __ATOMIC_RELAXED, __HIP_MEMORY_SCOPE_AGENT); }
__device__ __forceinline__ unsigned xb_add(unsigned* p, unsigned v) { return __hip_atomic_fetch_add(p, v, __ATOMIC_RELAXED, __HIP_MEMORY_SCOPE_AGENT); }
__device__ __forceinline__ unsigned xb_xcc_id() { return (unsigned)__builtin_amdgcn_s_getreg((3 << 11) | 20) & 0xFu; }
#define XB_SPIN(cond, bar) do { unsigned _sp = 0; while (cond) { __builtin_amdgcn_s_sleep(1); \
    if ((++_sp & 255u) == 0u) { if (xb_ld(&(bar)[XB_TMO])) break; if (_sp > XB_SPIN_CAP) { atomicAdd(&(bar)[XB_TMO], 1u); break; } } } } while (0)

struct XcdBarrier {
    unsigned* bar; unsigned x;
    volatile LAS unsigned* st;
};

__device__ __forceinline__ XcdBarrier xcd_barrier_post(unsigned* bar, volatile LAS unsigned* st) {
    XcdBarrier b; b.bar = bar; b.x = xb_xcc_id(); b.st = st;
    if (threadIdx.x == 0) (void)xb_add(&bar[XB_XCNT(b.x)], 1u);
    return b;
}
__device__ __forceinline__ void xcd_barrier_complete(unsigned* bar, unsigned x, unsigned& nloc, unsigned& nx) {
    const unsigned G = gridDim.x * gridDim.y * gridDim.z;
    unsigned sum, cnt, mine, sp = 0u;
    for (;;) {
        sum = 0u; cnt = 0u; mine = 0u;
#pragma unroll
        for (unsigned j = 0; j < 16; ++j) { const unsigned c = xb_ld(&bar[XB_XCNT(j)]); sum += c; cnt += (c > 0u) ? 1u : 0u; mine = (j == x) ? c : mine; }
        if (sum == G) break;
        __builtin_amdgcn_s_sleep(1);
        if ((++sp & 255u) == 0u) { if (xb_ld(&bar[XB_TMO])) break; if (sp > XB_SPIN_CAP) { atomicAdd(&bar[XB_TMO], 1u); break; } }
    }
    nloc = mine > 0u ? mine : 1u; nx = cnt > 0u ? cnt : 1u;
}

__device__ __forceinline__ void xcd_barrier(const XcdBarrier& b, const bool xb_is_leader) {
    asm volatile("s_waitcnt vmcnt(0)" ::: "memory");
    __syncthreads();
    if (xb_is_leader) {
        unsigned* bar = b.bar;
        __builtin_amdgcn_s_waitcnt(0);
        unsigned nloc = b.st[0], nx = b.st[1];
        if (nloc == 0u) { xcd_barrier_complete(bar, b.x, nloc, nx); b.st[0] = nloc; b.st[1] = nx; }
        const unsigned old = xb_add(&bar[XB_XSUB(b.x)], 1u);
        const unsigned gen = old / nloc;
        if (old + 1u == (gen + 1u) * nloc) {
            __builtin_amdgcn_fence(__ATOMIC_RELEASE, "agent");
            asm volatile("s_waitcnt vmcnt(0)" ::: "memory");
            const unsigned og = xb_add(&bar[XB_TOP], 1u);
            const unsigned tg = og / nx;
            if (og + 1u == (tg + 1u) * nx) xb_add(&bar[XB_TOPGEN], 1u);
            else XB_SPIN(xb_ld(&bar[XB_TOPGEN]) == tg, bar);
            __builtin_amdgcn_fence(__ATOMIC_ACQUIRE, "agent");
            xb_add(&bar[XB_XGEN(b.x)], 1u);
            asm volatile("s_waitcnt vmcnt(0)" ::: "memory");
        } else {
            XB_SPIN(xb_ld(&bar[XB_XGEN(b.x)]) == gen, bar);
            __builtin_amdgcn_fence(__ATOMIC_ACQUIRE, "agent");
            asm volatile("s_waitcnt vmcnt(0)" ::: "memory");
        }
    }
    __syncthreads();
}
namespace pg8 {
#define PG8_LAS __attribute__((address_space(3)))
typedef unsigned short bf16_t;
typedef short bf16x8 __attribute__((ext_vector_type(8)));
typedef float f32x4 __attribute__((ext_vector_type(4)));
typedef unsigned u32x4 __attribute__((ext_vector_type(4)));
constexpr int BM = 256, BK = 64, HALF = 128, HTB = HALF * BK * 2  , STAGE_BYTES = 8 * HTB, NXCD = 8, WGM = 8;

__host__ __device__ __forceinline__ int lds_byte(int r, int c) { const int st = (r >> 4) * 2 + (c >> 5), rr = r & 15, cc = c & 31, ob = rr * 64 + cc * 2; return st * 1024 + (ob ^ (((ob >> 9) & 1) << 5)); }
__host__ __device__ __forceinline__ void stage_rc(int b, int& R, int& C) { const int st = b / 1024, sb = b % 1024, swz = sb ^ (((sb >> 9) & 1) << 5); R = (st >> 1) * 16 + swz / 64; C = (st & 1) * 32 + (swz % 64) / 2; }
__host__ __device__ __forceinline__ int perm32(int rho) { const int n = rho >> 4, i = rho & 15; return 8 * (i >> 2) + 4 * n + (i & 3); }

struct Unit { int pm, pn; };
struct Gemm { const bf16_t* A; const bf16_t* Bt; int M, N, K; };

struct StaticOrder {
    int nM, nN, nwg, G, c;
    __host__ __device__ void init(int M, int N, int G_, int c_) { nM = M / BM; nN = N / BM; nwg = nM * nN; G = G_; c = c_; }
    __host__ __device__ bool next(int i, Unit& u) const {
        const long L = (long)i * G + c; if (L >= nwg) return false;
        int wgid = (int)L; { const int q = nwg / NXCD, r = nwg % NXCD, xcd = wgid % NXCD, off = wgid / NXCD; wgid = (xcd < r ? xcd * (q + 1) : r * (q + 1) + (xcd - r) * q) + off; }
        const int nig = WGM * nN, gid = wgid / nig, fm = gid * WGM, gsz = (nM - fm) < WGM ? (nM - fm) : WGM;
        u.pm = fm + ((wgid % nig) % gsz); u.pn = (wgid % nig) / gsz; return true;
    }
    __device__ __forceinline__ void a_ready(const Unit&) const {}
    __device__ __forceinline__ void done(const Unit&) const {}
};

#define BPERM(v, srclane) __builtin_bit_cast(float, __builtin_amdgcn_ds_bpermute((srclane) << 2, __builtin_bit_cast(int, (float)(v))))
#define PG8_EPI_BAR() do { asm volatile("s_waitcnt lgkmcnt(0)" ::: "memory"); __builtin_amdgcn_s_barrier(); asm volatile("" ::: "memory"); } while (0)

struct EpiQKV {
    static constexpr bool PERM = true, AFTER_DRAIN = false, WANTS_NEXT = false;
    bf16_t* Z; const float* gain;
    __device__ __forceinline__ void operator()(const f32x4 (&acc)[2][2][4][2], const Unit& u, int wr, int wc, int fr_in, int fq_in) const {
        int fr = fr_in, fq = fq_in; asm volatile("" : "+v"(fr), "+v"(fq));
        const int G = 4 * u.pn + wc;
        int gi; float sc = 1.f;
        if (G < 8) { gi = 0; sc = C2; } else if (G < 16) gi = 1; else if (G < 20) gi = -1; else if (G < 26) { gi = 2; sc = C2; } else if (G < 32) gi = 3;
        else if (G < 38) gi = -1; else if (G < 44) { gi = 4; sc = C2; } else if (G < 50) gi = 5; else gi = -1;
        f32x4 g[2][2];
#pragma unroll
        for (int bj = 0; bj < 2; ++bj) { g[bj][0] = (f32x4){1.f, 1.f, 1.f, 1.f}; g[bj][1] = g[bj][0]; }
        if (gi >= 0) {
#pragma unroll
            for (int bj = 0; bj < 2; ++bj) { const float* gp = gain + gi * 64 + 32 * bj + 8 * fq; g[bj][0] = *(const f32x4*)gp * sc; g[bj][1] = *(const f32x4*)(gp + 4) * sc; }
        }
        bf16_t* zb = Z + (size_t)(u.pm * BM + wr * 64 + fr) * ZP + u.pn * BM + wc * 64 + 8 * fq;
#pragma unroll
        for (int ai = 0; ai < 2; ++ai)
#pragma unroll
            for (int m = 0; m < 4; ++m) {
                float rstd = 1.f;
                if (gi >= 0) {
                    float s = 0.f;
#pragma unroll
                    for (int bj = 0; bj < 2; ++bj) { const f32x4 x0 = acc[ai][bj][m][0], x1 = acc[ai][bj][m][1];
                        s += (x0[0] * x0[0] + x0[1] * x0[1]) + (x0[2] * x0[2] + x0[3] * x0[3]) + (x1[0] * x1[0] + x1[1] * x1[1]) + (x1[2] * x1[2] + x1[3] * x1[3]); }
                    s = xor32_sum(xor16_sum(s));
                    rstd = fast_rsq(s * (1.0f / 64.0f) + EPS);
                }
#pragma unroll
                for (int bj = 0; bj < 2; ++bj) {
                    const f32x4 v0 = acc[ai][bj][m][0] * g[bj][0] * rstd, v1 = acc[ai][bj][m][1] * g[bj][1] * rstd;
                    u32x4 w; w.x = pk2(v0[0], v0[1]); w.y = pk2(v0[2], v0[3]); w.z = pk2(v1[0], v1[1]); w.w = pk2(v1[2], v1[3]);
                    *(u32x4*)(zb + (size_t)(ai * 128 + m * 16) * ZP + 32 * bj) = w;
                }
            }
    }
};

struct EpiPlain {
    static constexpr bool PERM = true, AFTER_DRAIN = false, WANTS_NEXT = false;
    bf16_t* Z;
    __device__ __forceinline__ void operator()(const f32x4 (&acc)[2][2][4][2], const Unit& u, int wr, int wc, int fr_in, int fq_in) const {
        int fr = fr_in, fq = fq_in; asm volatile("" : "+v"(fr), "+v"(fq));
#pragma unroll
        for (int ai = 0; ai < 2; ++ai)
#pragma unroll
            for (int m = 0; m < 4; ++m)
#pragma unroll
                for (int bj = 0; bj < 2; ++bj) {
                    const f32x4 v0 = acc[ai][bj][m][0], v1 = acc[ai][bj][m][1];
                    u32x4 w; w.x = pk2(v0[0], v0[1]); w.y = pk2(v0[2], v0[3]); w.z = pk2(v1[0], v1[1]); w.w = pk2(v1[2], v1[3]);
                    *(u32x4*)(Z + (size_t)(u.pm * BM + ai * 128 + wr * 64 + m * 16 + fr) * ZP + u.pn * BM + bj * HALF + wc * 32 + 8 * fq) = w;
                }
    }
};

#define BF16_LO(w) __uint_as_float((w) << 16)
#define BF16_HI(w) __uint_as_float((w) & 0xffff0000u)
struct EpiResid {
    static constexpr bool PERM = true, AFTER_DRAIN = false, WANTS_NEXT = false;
    const float* xbase; bf16_t* hb; u64_t* rsq;
    __device__ __forceinline__ void operator()(const f32x4 (&acc)[2][2][4][2], const Unit& u, int wr, int wc, int fr_in, int fq_in) const {
        int fr = fr_in, fq = fq_in; asm volatile("" : "+v"(fr), "+v"(fq));
#pragma unroll
        for (int ai = 0; ai < 2; ++ai)
#pragma unroll
            for (int m = 0; m < 4; ++m) {
                const int row = u.pm * BM + ai * 128 + wr * 64 + m * 16 + fr;
                float s = 0.f;
#pragma unroll
                for (int bj = 0; bj < 2; ++bj) {
                    const size_t off = (size_t)row * DM + u.pn * BM + bj * HALF + wc * 32 + 8 * fq;
                    f32x4 b0, b1;
                    if (xbase) { b0 = *(const f32x4*)(xbase + off); b1 = *(const f32x4*)(xbase + off + 4); }
                    else { const u32x4 q = *(const u32x4*)(hb + off);
                        b0 = (f32x4){BF16_LO(q.x), BF16_HI(q.x), BF16_LO(q.y), BF16_HI(q.y)}; b1 = (f32x4){BF16_LO(q.z), BF16_HI(q.z), BF16_LO(q.w), BF16_HI(q.w)}; }
                    const f32x4 h0 = b0 + acc[ai][bj][m][0], h1 = b1 + acc[ai][bj][m][1];
                    u32x4 w; w.x = pk2(h0[0], h0[1]); w.y = pk2(h0[2], h0[3]); w.z = pk2(h1[0], h1[1]); w.w = pk2(h1[2], h1[3]);
                    *(u32x4*)(hb + off) = w;
                    s += (h0[0] * h0[0] + h0[1] * h0[1]) + (h0[2] * h0[2] + h0[3] * h0[3]) + (h1[0] * h1[0] + h1[1] * h1[1]) + (h1[2] * h1[2] + h1[3] * h1[3]);
                }
                s = xor32_sum(xor16_sum(s));
                if (fq == 0) atomicAdd(rsq + row, (u64_t)(s * 16777216.0f));
                if (m == 3) asm volatile("" ::: "memory");
            }
    }
};

struct EpiSig {
    static constexpr bool PERM = true, AFTER_DRAIN = false, WANTS_NEXT = false;
    bf16_t* SG; const u64_t* rsq;
    __device__ __forceinline__ void operator()(const f32x4 (&acc)[2][2][4][2], const Unit& u, int wr, int wc, int fr_in, int fq_in) const {
        int fr = fr_in, fq = fq_in; asm volatile("" : "+v"(fr), "+v"(fq));
#pragma unroll
        for (int ai = 0; ai < 2; ++ai)
#pragma unroll
            for (int m = 0; m < 4; ++m) {
                const int row = u.pm * BM + ai * 128 + wr * 64 + m * 16 + fr;
                const float rs = row_rstd(rsq, row);
#pragma unroll
                for (int bj = 0; bj < 2; ++bj) {
                    const size_t off = (size_t)row * DM + u.pn * BM + bj * HALF + wc * 32 + 8 * fq;
                    const f32x4 a = acc[ai][bj][m][0] * rs, b = acc[ai][bj][m][1] * rs;
                    u32x4 w; w.x = pk2(sigmoidf_(a[0]), sigmoidf_(a[1])); w.y = pk2(sigmoidf_(a[2]), sigmoidf_(a[3]));
                    w.z = pk2(sigmoidf_(b[0]), sigmoidf_(b[1])); w.w = pk2(sigmoidf_(b[2]), sigmoidf_(b[3]));
                    *(u32x4*)(SG + off) = w;
                }
                asm volatile("" ::: "memory");
            }
    }
};

struct EpiMulAdd {
    static constexpr bool PERM = true, AFTER_DRAIN = false, WANTS_NEXT = false;
    const bf16_t* SG; bf16_t* hb; float* outf;
    __device__ __forceinline__ void operator()(const f32x4 (&acc)[2][2][4][2], const Unit& u, int wr, int wc, int fr_in, int fq_in) const {
        int fr = fr_in, fq = fq_in; asm volatile("" : "+v"(fr), "+v"(fq));
#pragma unroll
        for (int ai = 0; ai < 2; ++ai)
#pragma unroll
            for (int m = 0; m < 4; ++m)
#pragma unroll
                for (int bj = 0; bj < 2; ++bj) {
                    const size_t off = (size_t)(u.pm * BM + ai * 128 + wr * 64 + m * 16 + fr) * DM + u.pn * BM + bj * HALF + wc * 32 + 8 * fq;
                    const u32x4 s = *(const u32x4*)(SG + off), q = *(const u32x4*)(hb + off);
                    const f32x4 s0 = {BF16_LO(s.x), BF16_HI(s.x), BF16_LO(s.y), BF16_HI(s.y)}, s1 = {BF16_LO(s.z), BF16_HI(s.z), BF16_LO(s.w), BF16_HI(s.w)};
                    const f32x4 b0 = {BF16_LO(q.x), BF16_HI(q.x), BF16_LO(q.y), BF16_HI(q.y)}, b1 = {BF16_LO(q.z), BF16_HI(q.z), BF16_LO(q.w), BF16_HI(q.w)};
                    const f32x4 h0 = b0 + acc[ai][bj][m][0] * s0, h1 = b1 + acc[ai][bj][m][1] * s1;
                    if (outf) { *(f32x4*)(outf + off) = h0; *(f32x4*)(outf + off + 4) = h1; }
                    else { u32x4 w; w.x = pk2(h0[0], h0[1]); w.y = pk2(h0[2], h0[3]); w.z = pk2(h1[0], h1[1]); w.w = pk2(h1[2], h1[3]); *(u32x4*)(hb + off) = w; }
                    if (bj == 1 && (m & 1)) asm volatile("" ::: "memory");
                }
    }
};

struct EpiUp {
    static constexpr bool PERM = false, AFTER_DRAIN = false, WANTS_NEXT = true;
    bf16_t* A; const float* cw; const float* cb; float* edge; PG8_LAS float* xr; const u64_t* rsq; PG8_LAS float* prm; PG8_LAS float* rsd;
    __device__ __forceinline__ float ldp(int j, int pn) const { const int gv = j >> 9, tap = (j >> 7) & 3, col = gv * DFF + 128 * pn + (j & 127); return tap < 3 ? cw[tap * UPN + col] : cb[col]; }
    __device__ __forceinline__ void run(const f32x4 (&acc)[2][2][4][2], const Unit& u, const Unit& nxt, bool has_next, int ui, int wr, int wc, int fr_in, int fq_in) const {
        int fr = fr_in, fq = fq_in; asm volatile("" : "+v"(fr), "+v"(fq));
        const int tid = (wr * 4 + wc) * 64 + fq * 16 + fr;
        const int slot = ui & 1;
        if (ui == 0) {
            prm[slot * 1024 + tid] = ldp(tid, u.pn); prm[slot * 1024 + tid + 512] = ldp(tid + 512, u.pn);
            if (tid < 256) rsd[slot * 256 + tid] = row_rstd(rsq, u.pm * BM + tid);
            PG8_EPI_BAR();
        }
        float nx0 = 0.f, nx1 = 0.f, nrs = 1.f;
        if (has_next) { nx0 = ldp(tid, nxt.pn); nx1 = ldp(tid + 512, nxt.pn); if (tid < 256) nrs = rsq_sum(rsq, nxt.pm * BM + tid); }
        float* eg = edge + (size_t)(u.pm * 22 + u.pn) * 1024;
        float rs[2][4];
#pragma unroll
        for (int ai = 0; ai < 2; ++ai)
#pragma unroll
            for (int m = 0; m < 4; ++m) rs[ai][m] = rsd[slot * 256 + ai * 128 + wr * 64 + m * 16 + fr];
#pragma unroll
        for (int bj = 0; bj < 2; ++bj)
#pragma unroll
            for (int n = 0; n < 2; ++n) {
                const int colt = bj * 128 + wc * 32 + n * 16 + 4 * fq;
                if (fr >= 14) {
                    *(PG8_LAS f32x4*)(xr + ((0 + wr) * 2 + (fr - 14)) * 256 + colt) = acc[0][bj][3][n] * rs[0][3];
                    *(PG8_LAS f32x4*)(xr + ((2 + wr) * 2 + (fr - 14)) * 256 + colt) = acc[1][bj][3][n] * rs[1][3];
                    if (wr == 1) *(f32x4*)(eg + (2 + fr - 14) * 256 + colt) = acc[1][bj][3][n] * rs[1][3];
                }
                if (wr == 0 && fr < 2) *(f32x4*)(eg + fr * 256 + colt) = acc[0][bj][0][n] * rs[0][0];
            }
        PG8_EPI_BAR();
#pragma unroll
        for (int n = 0; n < 2; ++n) {
            const int cl = wc * 32 + n * 16 + 4 * fq, ch = u.pn * 128 + cl;
            const PG8_LAS float* pp = prm + slot * 1024 + cl;
            const f32x4 wg0 = *(const PG8_LAS f32x4*)(pp), wg1 = *(const PG8_LAS f32x4*)(pp + 128), wg2 = *(const PG8_LAS f32x4*)(pp + 256), bg = *(const PG8_LAS f32x4*)(pp + 384);
            const f32x4 wv0 = *(const PG8_LAS f32x4*)(pp + 512), wv1 = *(const PG8_LAS f32x4*)(pp + 640), wv2 = *(const PG8_LAS f32x4*)(pp + 768), bv = *(const PG8_LAS f32x4*)(pp + 896);
#pragma unroll
            for (int ai = 0; ai < 2; ++ai) {
                const int grp = 2 * ai + wr;
                f32x4 pg = {0.f, 0.f, 0.f, 0.f}, pv = {0.f, 0.f, 0.f, 0.f};
                if (grp > 0 && fr >= 14) { pg = *(const PG8_LAS f32x4*)(xr + ((grp - 1) * 2 + (fr - 14)) * 256 + cl); pv = *(const PG8_LAS f32x4*)(xr + ((grp - 1) * 2 + (fr - 14)) * 256 + 128 + cl); }
#pragma unroll
                for (int m = 0; m < 4; ++m) {
                    const f32x4 vg = acc[ai][0][m][n] * rs[ai][m], vv = acc[ai][1][m][n] * rs[ai][m];
                    f32x4 p1g, p2g, p1v, p2v;
#pragma unroll
                    for (int i = 0; i < 4; ++i) {
                        p1g[i] = DPPF(fr == 15 ? pg[i] : vg[i], 0x121); p2g[i] = DPPF(fr >= 14 ? pg[i] : vg[i], 0x122);
                        p1v[i] = DPPF(fr == 15 ? pv[i] : vv[i], 0x121); p2v[i] = DPPF(fr >= 14 ? pv[i] : vv[i], 0x122);
                    }
                    const f32x4 cgt = bg + wg0 * p2g + wg1 * p1g + wg2 * vg, cvl = bv + wv0 * p2v + wv1 * p1v + wv2 * vv;
                    float a[4];
#pragma unroll
                    for (int i = 0; i < 4; ++i) a[i] = cgt[i] * sigmoidf_(cgt[i]) * cvl[i];
                    u32x2 w; w.x = pk2(a[0], a[1]); w.y = pk2(a[2], a[3]);
                    *(u32x2*)(A + (size_t)(u.pm * BM + ai * 128 + wr * 64 + m * 16 + fr) * DFF + ch) = w;
                    pg = vg; pv = vv;
                }
            }
        }
        if (has_next) {
            prm[(slot ^ 1) * 1024 + tid] = nx0; prm[(slot ^ 1) * 1024 + tid + 512] = nx1;
            if (tid < 256) rsd[(slot ^ 1) * 256 + tid] = fast_rsq(nrs * (1.0f / DM) + EPS);
        }
    }
};
template <class Epi, class Sched, bool ALIGN_EPI = false, bool SP2 = false>
__device__ __forceinline__ void gemm_phase(PG8_LAS unsigned char* lds, const Gemm g, const Sched& S, const Epi& E, const int tid_arg) {
    int tid_l = tid_arg; asm volatile("" : "+v"(tid_l));
    const int tid = tid_l, wid = __builtin_amdgcn_readfirstlane(tid >> 6), lane = tid & 63, wr = wid >> 2, wc = wid & 3, fr = lane & 15, fq = lane >> 4;
    const int K = g.K, nt = K / BK;
    unsigned voffA[2], voffB[2];
#pragma unroll
    for (int i = 0; i < 2; ++i) { int R, C; stage_rc(tid * 16 + i * 8192, R, C); const int Rb = Epi::PERM ? ((R & ~31) + perm32(R & 31)) : R;
        voffA[i] = (unsigned)(R * K + C) * 2u; voffB[i] = (unsigned)(Rb * K + C) * 2u; }
    const size_t kstep = (size_t)(BK * 2);
    const size_t hstep = (size_t)HALF * K * 2;
    const size_t tstep = 2 * hstep;
    const unsigned ldsw = (unsigned)wid * 1024u;
    const int aoff = lds_byte(wr * 64 + fr, fq * 8), boff = lds_byte(wc * 32 + fr, fq * 8);
#define PG8_SA(b, h) (((b) * 2 + (h)) * HTB)
#define PG8_SB(b, h) ((4 + (b) * 2 + (h)) * HTB)
#define PG8_STAGE(bufoff, gbase, voff) do { _Pragma("unroll") for (int _i = 0; _i < 2; ++_i) \
        __builtin_amdgcn_global_load_lds((const unsigned*)((const char*)(gbase) + (voff)[_i]), (PG8_LAS unsigned*)(lds + (bufoff) + ldsw + _i * 8192), 16, 0, 0); } while (0)
#define PG8_LDA(dst, b, h) do { _Pragma("unroll") for (int m = 0; m < 4; ++m) _Pragma("unroll") for (int k = 0; k < 2; ++k) dst[m][k] = *(const PG8_LAS bf16x8*)(lds + PG8_SA(b, h) + aoff + m * 2048 + k * 1024); } while (0)
#define PG8_LDB(dst, b, h) do { _Pragma("unroll") for (int n = 0; n < 2; ++n) _Pragma("unroll") for (int k = 0; k < 2; ++k) dst[n][k] = *(const PG8_LAS bf16x8*)(lds + PG8_SB(b, h) + boff + n * 2048 + k * 1024); } while (0)
#define PG8_MMA(ai, bj, At, Bt) do { __builtin_amdgcn_s_setprio(1); _Pragma("unroll") for (int m = 0; m < 4; ++m) _Pragma("unroll") for (int n = 0; n < 2; ++n) _Pragma("unroll") for (int k = 0; k < 2; ++k) \
        acc[ai][bj][m][n] = __builtin_amdgcn_mfma_f32_16x16x32_bf16(Bt[n][k], At[m][k], acc[ai][bj][m][n], 0, 0, 0); __builtin_amdgcn_s_setprio(0); } while (0)
#define PG8_WAIT_V(n) asm volatile("s_waitcnt vmcnt(" #n ")" ::: "memory")
#define PG8_WAIT_L(n) asm volatile("s_waitcnt lgkmcnt(" #n ")" ::: "memory")
#define PG8_BAR __builtin_amdgcn_s_barrier()
#define PG8_SCHED __builtin_amdgcn_sched_barrier(0)
    Unit cur, nxt; int ui = 0;
    if (!S.next(0, cur)) return;
    f32x4 acc[2][2][4][2];
#pragma unroll
    for (int a = 0; a < 2; ++a)
#pragma unroll
        for (int b = 0; b < 2; ++b)
#pragma unroll
            for (int m = 0; m < 4; ++m)
#pragma unroll
                for (int n = 0; n < 2; ++n) acc[a][b][m][n] = (f32x4){0.f, 0.f, 0.f, 0.f};
    bf16x8 At[4][2], B0[2][2], B1[2][2];
    const char* cA = (const char*)g.A + (size_t)cur.pm * tstep; const char* cB = (const char*)g.Bt + (size_t)cur.pn * tstep;
    S.a_ready(cur);
    if constexpr (SP2) {
        PG8_STAGE(PG8_SB(0, 0), cB, voffB); PG8_STAGE(PG8_SB(0, 1), cB + hstep, voffB); PG8_STAGE(PG8_SA(0, 0), cA, voffA); PG8_STAGE(PG8_SA(0, 1), cA + hstep, voffA);
        if (wr == 1) PG8_BAR;
        PG8_WAIT_V(2); PG8_BAR;
        PG8_STAGE(PG8_SB(1, 0), cB + kstep, voffB); PG8_STAGE(PG8_SA(1, 0), cA + kstep, voffA); PG8_STAGE(PG8_SB(1, 1), cB + hstep + kstep, voffB);
        PG8_WAIT_V(6); PG8_BAR;
    } else {
        PG8_STAGE(PG8_SB(0, 0), cB, voffB); PG8_STAGE(PG8_SA(0, 0), cA, voffA); PG8_STAGE(PG8_SB(0, 1), cB + hstep, voffB); PG8_STAGE(PG8_SA(0, 1), cA + hstep, voffA);
        if (wr == 1) PG8_BAR;
        PG8_WAIT_V(4); PG8_BAR;
        PG8_STAGE(PG8_SB(1, 0), cB + kstep, voffB); PG8_STAGE(PG8_SA(1, 0), cA + kstep, voffA); PG8_STAGE(PG8_SB(1, 1), cB + hstep + kstep, voffB);
        PG8_WAIT_V(6); PG8_BAR;
    }
    for (;;) {
        const bool has_next = S.next(ui + 1, nxt);
        const char* nA = has_next ? (const char*)g.A + (size_t)nxt.pm * tstep : cA; const char* nB = has_next ? (const char*)g.Bt + (size_t)nxt.pn * tstep : cB;
        for (int t = 0; t < nt; t += 2) {
            const bool last = (t == nt - 2);
            const char* a1 = cA + (size_t)(t + 1) * kstep;
            const char* a2 = last ? nA : cA + (size_t)(t + 2) * kstep; const char* b2 = last ? nB : cB + (size_t)(t + 2) * kstep;
            const char* a3 = a2 + kstep; const char* b3 = b2 + kstep;
            if (last && has_next) S.a_ready(nxt);
            if constexpr (SP2) {
            PG8_LDB(B0, 0, 0); PG8_LDB(B1, 0, 1); PG8_SCHED; PG8_LDA(At, 0, 0); PG8_STAGE(PG8_SA(1, 1), a1 + hstep, voffA);
            PG8_WAIT_V(8); PG8_WAIT_L(0); PG8_BAR; PG8_MMA(0, 0, At, B0); PG8_MMA(0, 1, At, B1); PG8_BAR; PG8_SCHED;
            PG8_LDA(At, 0, 1); PG8_STAGE(PG8_SB(0, 0), b2, voffB); PG8_STAGE(PG8_SB(0, 1), b2 + hstep, voffB); PG8_STAGE(PG8_SA(0, 0), a2, voffA);
            PG8_WAIT_V(8); PG8_WAIT_L(0); PG8_BAR; PG8_MMA(1, 0, At, B0); PG8_MMA(1, 1, At, B1); PG8_BAR; PG8_SCHED;
            PG8_LDB(B0, 1, 0); PG8_LDB(B1, 1, 1); PG8_SCHED; PG8_LDA(At, 1, 0); PG8_STAGE(PG8_SA(0, 1), a2 + hstep, voffA);
            PG8_WAIT_V(8); PG8_WAIT_L(0); PG8_BAR; PG8_MMA(0, 0, At, B0); PG8_MMA(0, 1, At, B1); PG8_BAR; PG8_SCHED;
            PG8_LDA(At, 1, 1); PG8_STAGE(PG8_SB(1, 0), b3, voffB); PG8_STAGE(PG8_SB(1, 1), b3 + hstep, voffB); PG8_STAGE(PG8_SA(1, 0), a3, voffA);
            PG8_WAIT_V(8); PG8_WAIT_L(0); PG8_BAR; PG8_MMA(1, 0, At, B0); PG8_MMA(1, 1, At, B1); PG8_BAR; PG8_SCHED;
            } else {
            PG8_LDB(B0, 0, 0); PG8_SCHED; PG8_LDA(At, 0, 0); PG8_STAGE(PG8_SA(1, 1), a1 + hstep, voffA);
            PG8_WAIT_L(8); PG8_BAR; PG8_WAIT_L(0); PG8_MMA(0, 0, At, B0); PG8_BAR; PG8_SCHED;
            PG8_LDB(B1, 0, 1); PG8_STAGE(PG8_SB(0, 0), b2, voffB);
            PG8_BAR; PG8_WAIT_L(0); PG8_MMA(0, 1, At, B1); PG8_BAR;
            PG8_LDA(At, 0, 1); PG8_STAGE(PG8_SA(0, 0), a2, voffA);
            PG8_BAR; PG8_WAIT_L(0); PG8_MMA(1, 0, At, B0); PG8_BAR; PG8_SCHED;
            PG8_STAGE(PG8_SB(0, 1), b2 + hstep, voffB);
            PG8_WAIT_V(6); PG8_BAR; PG8_MMA(1, 1, At, B1); PG8_BAR;
            PG8_LDB(B0, 1, 0); PG8_SCHED; PG8_LDA(At, 1, 0); PG8_STAGE(PG8_SA(0, 1), a2 + hstep, voffA);
            PG8_WAIT_L(8); PG8_BAR; PG8_WAIT_L(0); PG8_MMA(0, 0, At, B0); PG8_BAR; PG8_SCHED;
            PG8_LDB(B1, 1, 1); PG8_STAGE(PG8_SB(1, 0), b3, voffB);
            PG8_BAR; PG8_WAIT_L(0); PG8_MMA(0, 1, At, B1); PG8_BAR;
            PG8_LDA(At, 1, 1); PG8_STAGE(PG8_SA(1, 0), a3, voffA);
            PG8_BAR; PG8_WAIT_L(0); PG8_MMA(1, 0, At, B0); PG8_BAR; PG8_SCHED;
            PG8_STAGE(PG8_SB(1, 1), b3 + hstep, voffB);
            PG8_WAIT_V(6); PG8_BAR; PG8_MMA(1, 1, At, B1); PG8_BAR;
            }
        }
        if constexpr (ALIGN_EPI) { if (wr == 0) PG8_BAR; }
        if constexpr (!Epi::AFTER_DRAIN) { if constexpr (Epi::WANTS_NEXT) E.run(acc, cur, nxt, has_next, ui, wr, wc, fr, fq); else E(acc, cur, wr, wc, fr, fq); S.done(cur); }
        if (!has_next) break;
#pragma unroll
        for (int a = 0; a < 2; ++a)
#pragma unroll
            for (int b = 0; b < 2; ++b)
#pragma unroll
                for (int m = 0; m < 4; ++m)
#pragma unroll
                    for (int n = 0; n < 2; ++n) acc[a][b][m][n] = (f32x4){0.f, 0.f, 0.f, 0.f};
        cur = nxt; cA = nA; cB = nB; ++ui;
        if constexpr (ALIGN_EPI) { if (wr == 1) PG8_BAR; }
    }
    PG8_WAIT_V(0);
    if constexpr (!ALIGN_EPI) { if (wr == 0) PG8_BAR; }
    PG8_BAR;
    if constexpr (Epi::AFTER_DRAIN) { E.fused(acc, cur, wr, wc, fr, fq, lds, wid, lane); S.done(cur); }
#undef PG8_SA
#undef PG8_SB
#undef PG8_STAGE
#undef PG8_LDA
#undef PG8_LDB
#undef PG8_MMA
#undef PG8_WAIT_V
#undef PG8_WAIT_L
#undef PG8_BAR
#undef PG8_SCHED
}
}
template <int MODE> __device__ __forceinline__ int srccol(int n) {
    if (MODE == 1) {
        const int ct = n & 255, lg = (n & ~255) + ((ct >> 5) & 3) * 64 + (ct >> 7) * 32 + (ct & 31);
        return lg < 2432 ? lg : lg + 6; }
    if (MODE == 2) { const int pn = n >> 8, j = n & 255; return j < 128 ? 128 * pn + j : DFF + 128 * pn + (j - 128); }
    return n;
}
template <int MODE> __device__ __forceinline__ void transpose_item(const float* W, int K, int Nsrc, int Ndst, bf16_t* WT, LAS float* scr, int item, int lane, const float* kgain = nullptr) {
    const int nblk = Ndst / 32, kb = item / nblk, nb = item % nblk, k0 = 64 * kb, n0 = 32 * nb;
    const int sc = srccol<MODE>(n0 + (lane & 31));
#pragma unroll
    for (int i = 0; i < 32; ++i) { const int kk = 2 * i + (lane >> 5); scr[kk * 33 + (lane & 31)] = W[(size_t)(k0 + kk) * Nsrc + sc] * (kgain ? kgain[k0 + kk] : 1.0f); }
    asm volatile("s_waitcnt lgkmcnt(0)" ::: "memory");
    const int c = lane & 7;
#pragma unroll
    for (int j = 0; j < 4; ++j) { const int n = (lane >> 3) + 8 * j; const LAS float* s = scr + (8 * c) * 33 + n;
        u32x4 o; o.x = pk2(s[0 * 33], s[1 * 33]); o.y = pk2(s[2 * 33], s[3 * 33]); o.z = pk2(s[4 * 33], s[5 * 33]); o.w = pk2(s[6 * 33], s[7 * 33]);
        *(u32x4*)(WT + (size_t)(n0 + n) * K + k0 + 8 * c) = o; }
    asm volatile("s_waitcnt lgkmcnt(0)" ::: "memory");
}

template <bool FG, bool BIN = false> __device__ __forceinline__ void norm_phase(const float* hin, const float* gain, bf16_t* out, const float* win, const float* fbias, float* logf, int gw, int NGW, int lane) {
    float g[16];
#pragma unroll
    for (int i = 0; i < 2; ++i) { const int c0 = 8 * (lane + 64 * i); const f32x4 a = *(const f32x4*)(gain + c0), b = *(const f32x4*)(gain + c0 + 4);
        g[8 * i + 0] = a[0]; g[8 * i + 1] = a[1]; g[8 * i + 2] = a[2]; g[8 * i + 3] = a[3]; g[8 * i + 4] = b[0]; g[8 * i + 5] = b[1]; g[8 * i + 6] = b[2]; g[8 * i + 7] = b[3]; }
    float wf[6][16]; float fb[6];
    if (FG) {
#pragma unroll
        for (int i = 0; i < 2; ++i)
#pragma unroll
            for (int e = 0; e < 8; ++e) { const float* wp = win + (size_t)(8 * (lane + 64 * i) + e) * INC + 2432;
#pragma unroll
                for (int j = 0; j < 6; ++j) wf[j][8 * i + e] = wp[j] * g[8 * i + e]; }
#pragma unroll
        for (int j = 0; j < 6; ++j) fb[j] = fbias[j];
    }
    f32x4 nx[4];
    const bf16_t* hbin = (const bf16_t*)hin;
#define NORM_LD(rowi) do { _Pragma("unroll") for (int i = 0; i < 2; ++i) { const int c0 = 8 * (lane + 64 * i); \
        if (BIN) { const u32x4 q_ = *(const u32x4*)(hbin + (size_t)(rowi) * DM + c0); \
            nx[2 * i] = (f32x4){__uint_as_float(q_.x << 16), __uint_as_float(q_.x & 0xffff0000u), __uint_as_float(q_.y << 16), __uint_as_float(q_.y & 0xffff0000u)}; \
            nx[2 * i + 1] = (f32x4){__uint_as_float(q_.z << 16), __uint_as_float(q_.z & 0xffff0000u), __uint_as_float(q_.w << 16), __uint_as_float(q_.w & 0xffff0000u)}; } \
        else { nx[2 * i] = *(const f32x4*)(hin + (size_t)(rowi) * DM + c0); nx[2 * i + 1] = *(const f32x4*)(hin + (size_t)(rowi) * DM + c0 + 4); } } } while (0)
    if (gw < T) NORM_LD(gw);
    for (int row = gw; row < T; row += NGW) {
        float x[16];
#pragma unroll
        for (int i = 0; i < 4; ++i) { x[4 * i + 0] = nx[i][0]; x[4 * i + 1] = nx[i][1]; x[4 * i + 2] = nx[i][2]; x[4 * i + 3] = nx[i][3]; }
        if (row + NGW < T) NORM_LD(row + NGW);
        float ss = 0.f;
#pragma unroll
        for (int e = 0; e < 16; ++e) ss += x[e] * x[e];
        ss = wave_sum(ss);
        const float rstd = fast_rsq(ss * (1.0f / DM) + EPS);
#pragma unroll
        for (int i = 0; i < 2; ++i) { u32x4 w;
            w.x = pk2(x[8 * i + 0] * rstd * g[8 * i + 0], x[8 * i + 1] * rstd * g[8 * i + 1]); w.y = pk2(x[8 * i + 2] * rstd * g[8 * i + 2], x[8 * i + 3] * rstd * g[8 * i + 3]);
            w.z = pk2(x[8 * i + 4] * rstd * g[8 * i + 4], x[8 * i + 5] * rstd * g[8 * i + 5]); w.w = pk2(x[8 * i + 6] * rstd * g[8 * i + 6], x[8 * i + 7] * rstd * g[8 * i + 7]);
            *(u32x4*)(out + (size_t)row * DM + 8 * (lane + 64 * i)) = w; }
        if (FG) {
            float mine = 0.f;
#pragma unroll
            for (int j = 0; j < 6; ++j) { float d = 0.f;
#pragma unroll
                for (int e = 0; e < 16; ++e) d += x[e] * wf[j][e];
                d = wave_sum(d) * rstd + fb[j];
                if (lane == j) mine = d; }
            if (lane < 6) { const float v = mine; logf[(size_t)row * 6 + lane] = fminf(v, 0.f) - log1pf(expf(-fabsf(v))); }
        }
    }
}

__device__ __forceinline__ void scan_unit(const float* logf, float* F2, int bh, LAS double* sd, int tid) {
    const int b = bh / 6, h = bh % 6;
    const float* src = logf + (size_t)b * SEQ * 6 + h;
    double loc[8]; double run = 0.0;
#pragma unroll
    for (int i = 0; i < 8; ++i) { run += (double)src[(size_t)(8 * tid + i) * 6]; loc[i] = run; }
    sd[tid] = run;
    __syncthreads();
    if (tid < 64) {
        double v[8], tot = 0.0;
#pragma unroll
        for (int k = 0; k < 8; ++k) { v[k] = tot; tot += sd[8 * tid + k]; }
        double inc = tot;
#pragma unroll
        for (int o = 1; o < 64; o <<= 1) {
            const int src = (tid >= o) ? tid - o : tid;
            const unsigned long long u_ = __builtin_bit_cast(unsigned long long, inc);
            const unsigned lo_ = (unsigned)__builtin_amdgcn_ds_bpermute(src << 2, (int)(unsigned)u_), hi_ = (unsigned)__builtin_amdgcn_ds_bpermute(src << 2, (int)(unsigned)(u_ >> 32));
            const double up = __builtin_bit_cast(double, ((unsigned long long)hi_ << 32) | lo_);
            if (tid >= o) inc += up;
        }
        const double base = inc - tot;
#pragma unroll
        for (int k = 0; k < 8; ++k) sd[8 * tid + k] = base + v[k];
    }
    __syncthreads();
    const double off = sd[tid];
#pragma unroll
    for (int i = 0; i < 8; ++i) F2[(size_t)bh * SEQ + 8 * tid + i] = (float)((off + loc[i]) * 1.4426950408889634);
    __syncthreads();
}

__device__ __forceinline__ void fix_rows(bf16_t* A, const float* edge, const float* cw, const float* cb, int pm, int tid) {
    const bool hasprev = (pm & 15) != 0;
#pragma unroll
    for (int it_ = 0; it_ < 6; ++it_) {
        const int ch = tid + 512 * it_; if (ch >= DFF) break;
        const int pn = ch >> 7, ci = ch & 127;
        const float* E = edge + (size_t)(pm * 22 + pn) * 1024;
        const float* P = hasprev ? edge + (size_t)((pm - 1) * 22 + pn) * 1024 : E;
        float c0[2], c1[2];
#pragma unroll
        for (int gv = 0; gv < 2; ++gv) {
            const int col = gv * 128 + ci, cc = gv * DFF + ch;
            const float u0 = E[col], u1 = E[256 + col], p254 = hasprev ? P[512 + col] : 0.f, p255 = hasprev ? P[768 + col] : 0.f;
            const float w0 = cw[cc], w1 = cw[UPN + cc], w2 = cw[2 * UPN + cc], bb = cb[cc];
            c0[gv] = bb + w0 * p254 + w1 * p255 + w2 * u0; c1[gv] = bb + w0 * p255 + w1 * u0 + w2 * u1;
        }
        const float a0 = c0[0] * sigmoidf_(c0[0]) * c0[1], a1 = c1[0] * sigmoidf_(c1[0]) * c1[1];
        A[(size_t)(pm * 256) * DFF + ch] = (bf16_t)(pk2(a0, 0.f) & 0xffffu);
        A[(size_t)(pm * 256 + 1) * DFF + ch] = (bf16_t)(pk2(a1, 0.f) & 0xffffu);
    }
}

struct AttnCtx { const bf16_t* Z; bf16_t* O; const float* F2; const float* rel; const float* subln; float lam, oml, Mb0, Mb1, Mb2; };
__device__ __forceinline__ int crow(int r, int hi) { return (r & 3) + 8 * (r >> 2) + 4 * hi; }
#define MFMA32(a, b, c) __builtin_amdgcn_mfma_f32_32x32x16_bf16((a), (b), (c), 0, 0, 0)
typedef short v4i16_t __attribute__((ext_vector_type(4)));
__device__ __forceinline__ s16x4 vtr(const LAS unsigned char* p) { return __builtin_bit_cast(s16x4, __builtin_amdgcn_ds_read_tr16_b64_v4i16((LAS v4i16_t*)p)); }

constexpr int AL_K = 0, AL_V = 32768, AL_F = 65536, AL_REL = 66560, AL_WS = 68608, AL_U = 69632;

template <int TYPE> __device__ __forceinline__ void attn_unit(const AttnCtx& C, int b, int h, int qb, LAS unsigned char* lds, int tid_in, unsigned* counter) {
    int tid = tid_in; asm volatile("" : "+v"(tid));
    const int lane = tid & 63, w = __builtin_amdgcn_readfirstlane(tid >> 6), r32 = lane & 31, hi = lane >> 5;
    const int cq = 4 * qb + (w >> 1);
    const float sl2 = (TYPE == 0) ? exp2f(-2.0f * (float)(h + 1)) * LOG2E : 0.f;
    const float dmax = (TYPE == 0) ? (160.0f + C.Mb0) / sl2 : 0.f;
    int t0 = 0; const int t1 = 4 * qb + 4;
    if (TYPE == 2) t0 = (4 * qb - 8 > 0) ? 4 * qb - 8 : 0;
    if (TYPE == 0) { const float num = (float)(256 * qb - 63) - dmax; if (num >= 0.f) t0 = (int)(num * (1.0f / 64.0f)) + 1; }
    int tfirst = 0;
    if (TYPE == 1) {
        const float* f2t = C.F2 + (size_t)(b * 6 + h) * SEQ;
        const float fend = f2t[64 * lane + 63];
        const float fq_unit = f2t[256 * qb], fq_wave = f2t[256 * qb + 32 * w];
        const unsigned long long need_u = __ballot(fq_unit - fend > -160.0f), need_w = __ballot(fq_wave - fend > -160.0f);
        t0 = need_u ? (int)__builtin_ctzll(need_u) : 0; tfirst = need_w ? (int)__builtin_ctzll(need_w) : 0;
        if (t0 > 4 * qb) t0 = 4 * qb;
    }
    t0 &= ~1;
    const int sq = 256 * qb + 32 * w + r32;
    const size_t rowb = (size_t)b * SEQ;
    LAS unsigned char* Kb = lds + AL_K; LAS unsigned char* Vb = lds + AL_V;
    LAS float* Fb = (LAS float*)(lds + AL_F); LAS float* relb = (LAS float*)(lds + AL_REL); LAS float* wscr = (LAS float*)(lds + AL_WS) + w * 32;
    constexpr int NPASS = (TYPE == 0) ? 2 : 1;
    unsigned nclaim = 0u;
    const float Mb = (TYPE == 0) ? C.Mb0 : (TYPE == 1) ? C.Mb1 : C.Mb2;
    const int kwoff = w * 1024 + lane * 16, vwoff = ((tid & 7) >> 2) * 4096 + (tid >> 3) * 64 + (tid & 3) * 16;
    const int vb0 = ((lane >> 4) & 1) * 32 + (lane & 3) * 8 + (4 * hi + ((lane & 15) >> 2)) * 64;
    f32x16 o[2], o1[2];
    if (TYPE == 2) { for (int i = tid; i < 257; i += 512) relb[i] = C.rel[h * 257 + i] * LOG2E; }
#pragma unroll
    for (int pass = 0; pass < NPASS; ++pass) {
        int qcol, kcol, vcol;
        if (TYPE == 0) { qcol = pass * 256 + 64 * h; kcol = 512 + pass * 256 + 64 * h; vcol = 1024 + 64 * h; }
        else if (TYPE == 1) { qcol = 1280 + 64 * h; kcol = 1664 + 64 * h; vcol = 2048 + 64 * h; }
        else { qcol = 2432 + 64 * h; kcol = 2816 + 64 * h; vcol = 3200 + 64 * h; }
        const bf16_t* Qp = C.Z + (rowb + sq) * ZP + qcol + 8 * hi;
        bf16x8 qr[4];
#pragma unroll
        for (int d0 = 0; d0 < 4; ++d0) qr[d0] = *(const bf16x8*)(Qp + 16 * d0);
        float cinit = -Mb;
        const float* f2p = C.F2 + (size_t)(b * 6 + h) * SEQ;
        if (TYPE == 1) cinit += f2p[sq];
        f32x16 cvec, zvec;
#pragma unroll
        for (int r = 0; r < 16; ++r) { cvec[r] = cinit; zvec[r] = 0.f; }
#pragma unroll
        for (int r = 0; r < 16; ++r) { o[0][r] = 0.f; o[1][r] = 0.f; }
        float lsum = 0.f;
        const bf16_t* kg = C.Z + (rowb + lane) * ZP + kcol + 8 * w;
        const bf16_t* vg = C.Z + (rowb + (tid >> 3)) * ZP + vcol + 8 * (tid & 7);
        u32x4 kreg = *(const u32x4*)(kg + (size_t)t0 * 64 * ZP), vreg = *(const u32x4*)(vg + (size_t)t0 * 64 * ZP);
        u32x4 kreg2 = *(const u32x4*)(kg + (size_t)(t0 + 1) * 64 * ZP), vreg2 = *(const u32x4*)(vg + (size_t)(t0 + 1) * 64 * ZP);
        float freg = 0.f, freg2 = 0.f;
        if (TYPE == 1 && tid < 64) { freg = f2p[t0 * 64 + tid]; freg2 = f2p[(t0 + 1) * 64 + tid]; }
        __syncthreads();
        for (int t = t0; t < t1; ++t) {
            const int bo = (t & 3) * 8192;
            if ((t & 1) == 0) {
                const int bo1 = ((t + 1) & 3) * 8192;
                *(LAS u32x4*)(Kb + bo + kwoff) = kreg; *(LAS u32x4*)(Vb + bo + vwoff) = vreg;
                *(LAS u32x4*)(Kb + bo1 + kwoff) = kreg2; *(LAS u32x4*)(Vb + bo1 + vwoff) = vreg2;
                if (TYPE == 1 && tid < 64) { Fb[(t & 3) * 64 + tid] = freg; Fb[((t + 1) & 3) * 64 + tid] = freg2; }
                if (t + 2 < t1) {
                    kreg = *(const u32x4*)(kg + (size_t)(t + 2) * 64 * ZP); vreg = *(const u32x4*)(vg + (size_t)(t + 2) * 64 * ZP);
                    kreg2 = *(const u32x4*)(kg + (size_t)(t + 3) * 64 * ZP); vreg2 = *(const u32x4*)(vg + (size_t)(t + 3) * 64 * ZP);
                    if (TYPE == 1 && tid < 64) { freg = f2p[(t + 2) * 64 + tid]; freg2 = f2p[(t + 3) * 64 + tid]; }
                }
                if (pass == NPASS - 1 && t + 2 >= t1 && tid == 0) nclaim = atomicAdd(counter, 1u);
                __syncthreads();
            }
            const bool active = (TYPE == 2) ? (t >= cq - 8 && t <= cq) : (TYPE == 0) ? (t <= cq && (float)(256 * qb + 32 * w - 64 * t - 63) < dmax) : (t <= cq && t >= tfirst);
            if (active) {
                f32x16 p0, p1;
                const LAS unsigned char* kp = Kb + bo + hi * 1024 + r32 * 16;
#pragma unroll
                for (int d0 = 0; d0 < 4; ++d0) {
                    const bf16x8 a0 = *(const LAS bf16x8*)(kp + d0 * 2048), a1 = *(const LAS bf16x8*)(kp + d0 * 2048 + 512);
                    if (d0 == 0) { p0 = MFMA32(a0, qr[0], (TYPE == 1 ? cvec : zvec)); p1 = MFMA32(a1, qr[0], (TYPE == 1 ? cvec : zvec)); }
                    else { p0 = MFMA32(a0, qr[d0], p0); p1 = MFMA32(a1, qr[d0], p1); }
                }
                const int xi = sq - 64 * t - 4 * hi;
                if (TYPE == 0) {
                    const float xf = (float)xi;
#pragma unroll
                    for (int r = 0; r < 16; ++r) { const float c = (float)((r & 3) + 8 * (r >> 2));
                        p0[r] = fast_exp2(p0[r] - sl2 * fabsf(xf - c)); p1[r] = fast_exp2(p1[r] - sl2 * fabsf(xf - (c + 32.f))); }
                } else if (TYPE == 1) {
                    const LAS float* fp = Fb + (t & 3) * 64 + 4 * hi;
#pragma unroll
                    for (int g = 0; g < 4; ++g) { const f32x4 fa = *(const LAS f32x4*)(fp + 8 * g), fb2 = *(const LAS f32x4*)(fp + 32 + 8 * g);
#pragma unroll
                        for (int i = 0; i < 4; i += 2) {
                            const f32x2_t d0_ = (f32x2_t){p0[4 * g + i], p0[4 * g + i + 1]} - (f32x2_t){fa[i], fa[i + 1]}, d1_ = (f32x2_t){p1[4 * g + i], p1[4 * g + i + 1]} - (f32x2_t){fb2[i], fb2[i + 1]};
                            p0[4 * g + i] = fast_exp2(d0_[0]); p0[4 * g + i + 1] = fast_exp2(d0_[1]); p1[4 * g + i] = fast_exp2(d1_[0]); p1[4 * g + i + 1] = fast_exp2(d1_[1]); } }
                    if (t == cq) { const int qrel = 32 * (w & 1) + r32;
#pragma unroll
                        for (int r = 0; r < 16; ++r) { const int kv = crow(r, hi); if (kv > qrel) p0[r] = 0.f; if (kv + 32 > qrel) p1[r] = 0.f; } }
                } else {
                    if (cq - t >= 3) { const float bc = relb[256];
#pragma unroll
                        for (int r = 0; r < 16; ++r) { p0[r] = fast_exp2(p0[r] + bc); p1[r] = fast_exp2(p1[r] + bc); }
                    } else {
#pragma unroll
                        for (int r = 0; r < 16; ++r) { const int c = (r & 3) + 8 * (r >> 2);
                            int i0 = xi - c; i0 = i0 < -128 ? -128 : (i0 > 128 ? 128 : i0); int i1 = xi - c - 32; i1 = i1 < -128 ? -128 : (i1 > 128 ? 128 : i1);
                            p0[r] = fast_exp2(p0[r] + relb[i0 + 128]); p1[r] = fast_exp2(p1[r] + relb[i1 + 128]); }
                    }
                }
                f32x2_t a2 = {0.f, 0.f};
#pragma unroll
                for (int r = 0; r < 16; r += 2) { a2 += (f32x2_t){p0[r], p0[r + 1]}; a2 += (f32x2_t){p1[r], p1[r + 1]}; }
                lsum += a2[0] + a2[1];
                bf16x8 pa[4];
#pragma unroll
                for (int s = 0; s < 2; ++s) {
                    u32x4 a, c2;
                    a.x = pk2(p0[8 * s + 0], p0[8 * s + 1]); a.y = pk2(p0[8 * s + 2], p0[8 * s + 3]); a.z = pk2(p0[8 * s + 4], p0[8 * s + 5]); a.w = pk2(p0[8 * s + 6], p0[8 * s + 7]);
                    c2.x = pk2(p1[8 * s + 0], p1[8 * s + 1]); c2.y = pk2(p1[8 * s + 2], p1[8 * s + 3]); c2.z = pk2(p1[8 * s + 4], p1[8 * s + 5]); c2.w = pk2(p1[8 * s + 6], p1[8 * s + 7]);
                    pa[s] = __builtin_bit_cast(bf16x8, a); pa[2 + s] = __builtin_bit_cast(bf16x8, c2);
                }
                const LAS unsigned char* vp = Vb + bo + vb0;
#pragma unroll
                for (int dh = 0; dh < 2; ++dh)
#pragma unroll
                    for (int ks = 0; ks < 4; ++ks) {
                        const s16x4 lo = vtr(vp + dh * 4096 + ks * 1024), hh = vtr(vp + dh * 4096 + ks * 1024 + 512);
                        const bf16x8 vf = {lo[0], lo[1], lo[2], lo[3], hh[0], hh[1], hh[2], hh[3]};
                        o[dh] = MFMA32(pa[ks], vf, o[dh]);
                    }
            }
        }
        const float ltot = xor32_sum(lsum);
        if (hi == 0) wscr[r32] = 1.0f / ltot;
#pragma unroll
        for (int g = 0; g < 4; ++g) { const f32x4 iv = *(const LAS f32x4*)(wscr + 8 * g + 4 * hi);
#pragma unroll
            for (int i = 0; i < 4; ++i) { o[0][4 * g + i] *= iv[i]; o[1][4 * g + i] *= iv[i]; } }
        if (TYPE == 0) {
            if (pass == 0) { o1[0] = o[0]; o1[1] = o[1]; }
            else {
#pragma unroll
                for (int r = 0; r < 16; ++r) { o[0][r] = o1[0][r] - C.lam * o[0][r]; o[1][r] = o1[1][r] - C.lam * o[1][r]; }
            }
        }
    }
    int ocol;
    if (TYPE == 0) {
        ocol = 64 * h;
        const float g0 = C.subln[r32], g1 = C.subln[32 + r32];
#pragma unroll
        for (int r = 0; r < 16; ++r) {
            float ss = o[0][r] * o[0][r] + o[1][r] * o[1][r];
            ss = xor16_sum(row16_sum(ss));
            const float rs = C.oml * fast_rsq(ss * (1.0f / 64.0f) + EPS);
            o[0][r] *= rs * g0; o[1][r] *= rs * g1;
        }
    } else if (TYPE == 1) ocol = 256 + 64 * h; else ocol = 640 + 64 * h;
    bf16_t* Op = C.O + (rowb + 256 * qb + 32 * w) * DM + ocol + r32;
#pragma unroll
    for (int r = 0; r < 16; ++r) {
        const size_t ro = (size_t)crow(r, hi) * DM;
        Op[ro] = (bf16_t)(pk2(o[0][r], 0.f) & 0xffffu); Op[ro + 32] = (bf16_t)(pk2(o[1][r], 0.f) & 0xffffu);
    }
    if (tid == 0) ((LAS unsigned*)(lds + AL_U))[0] = nclaim;
}

constexpr int ATT_UNITS = 2048;
__device__ __forceinline__ void attn_phase(const AttnCtx& C, unsigned* counter, LAS unsigned char* lds, int tid) {
    LAS unsigned* ub = (LAS unsigned*)(lds + AL_U);
    __syncthreads();
    if (tid == 0) ub[0] = atomicAdd(counter, 1u);
    for (;;) {
        __syncthreads();
        const int u = (int)ub[0];
        if (u >= ATT_UNITS) break;
        int ty, ub_, uh, uq;
        if (u < 256) { ty = 0; ub_ = (u & 31) >> 2; uh = u & 3; uq = 15 - (u >> 5); }
        else if (u < 1280) { const int v = u - 256, q = 7 - (v >> 7), wv = v & 127;
            if (wv < 32) { ty = 0; ub_ = wv >> 2; uh = wv & 3; uq = q; }
            else if (wv < 80) { ty = 1; ub_ = (wv - 32) / 6; uh = (wv - 32) % 6; uq = 2 * q + 1; }
            else { ty = 1; ub_ = (wv - 80) / 6; uh = (wv - 80) % 6; uq = 2 * q; } }
        else { const int v = u - 1280; ty = 2; ub_ = (v % 48) / 6; uh = (v % 48) % 6; uq = 15 - v / 48; }
        if (ty == 0) attn_unit<0>(C, ub_, uh, uq, lds, tid, counter);
        else if (ty == 1) attn_unit<1>(C, ub_, uh, uq, lds, tid, counter);
        else attn_unit<2>(C, ub_, uh, uq, lds, tid, counter);
    }
}
struct Args { const float* in[18]; float* out; unsigned char* ws; };
constexpr int LDS_TOTAL = 149760, LDS_XCH = 131072, LDS_PRM = LDS_XCH + 8256, LDS_RSD = LDS_PRM + 8192;
#ifdef PROBE_SYNC2
#define GSYNC() do { xcd_barrier(xbar, K_TID == 0); xcd_barrier(xbar, K_TID == 0); } while (0)
#else
#define GSYNC() xcd_barrier(xbar, K_TID == 0)
#endif
__device__ __forceinline__ int lane_fresh() { unsigned m = ~0u; asm volatile("" : "+s"(m)); int t = (int)__builtin_amdgcn_mbcnt_hi(m, __builtin_amdgcn_mbcnt_lo(m, 0u)); asm volatile("" : "+v"(t)); return t; }
typedef const __attribute__((address_space(4))) Args* kargs_t;
__device__ __forceinline__ kargs_t kargs() { kargs_t p = (kargs_t)__builtin_amdgcn_kernarg_segment_ptr(); asm volatile("" : "+s"(p)); return p; }
#define AIN(i) (kargs()->in[i])
#define AOUT (kargs()->out)
#define AWS (kargs()->ws)
#define P_HN ((bf16_t*)(AWS + WS_HN))
#define P_Zb ((bf16_t*)(AWS + WS_Z))
#define P_LOGF ((float*)(AWS + WS_LOGF))
#define P_F2 ((float*)(AWS + WS_F2))
#define P_EDGE ((float*)(AWS + WS_EDGE))
#define P_PB ((bf16_t*)(AWS + WS_PB))
#define P_HB ((bf16_t*)(AWS + WS_HB))
#define P_RSQ ((u64_t*)(AWS + WS_RSQ))

__global__ void __launch_bounds__(512, 2) fwd_megakernel(Args a) {
    __shared__ __attribute__((aligned(16))) unsigned char lds_raw[LDS_TOTAL];
    cg::grid_group grid = cg::this_grid();
    LAS unsigned char* lds = (LAS unsigned char*)lds_raw;
    const int G = gridDim.x, bx = blockIdx.x, NGW = G * 8;
    const int wave_s = __builtin_amdgcn_readfirstlane((int)threadIdx.x >> 6);
#define K_TID ((wave_s << 6) | lane_fresh())
#define K_LANE (lane_fresh())
#define K_WAVE (wave_s)
#define K_GW (bx * 8 + K_WAVE)
    volatile LAS unsigned* xst = (volatile LAS unsigned*)(lds + LDS_XCH + 8192);
    if (K_TID < 4) xst[K_TID] = 0u;
    __syncthreads();
    XcdBarrier xbar = xcd_barrier_post((unsigned*)(AWS + WS_CTL), xst);
#ifdef PROBE_P0X2
    for (int rep_ = 0; rep_ < 2; ++rep_)
#endif
    {
        LAS float* scr = (LAS float*)(lds + K_WAVE * 8448);
        constexpr int I_IN = 16 * 112, I_OUT = 16 * 32, I_UP = 16 * 176, I_DN = 44 * 32, I_GT = 16 * 32, I_PJ = 4 * 32, I_L = I_IN + I_OUT + I_UP + I_DN + I_GT + I_PJ;
        for (int it = K_GW; it < 2 * I_L; it += NGW) {
            const int l = it / I_L; int r = it % I_L;
            if (r < I_IN) { transpose_item<1>(AIN(3) + (size_t)l * DM * INC, DM, INC, ZP, (bf16_t*)(AWS + WS_WIN + l * SZ_WIN), scr, r, K_LANE); continue; } r -= I_IN;
            if (r < I_OUT) { transpose_item<0>(AIN(9) + (size_t)l * DM * DM, DM, DM, DM, (bf16_t*)(AWS + WS_WOUT + l * SZ_WOUT), scr, r, K_LANE); continue; } r -= I_OUT;
            if (r < I_UP) { transpose_item<2>(AIN(11) + (size_t)l * DM * UPN, DM, UPN, UPN, (bf16_t*)(AWS + WS_WUP + l * SZ_WUP), scr, r, K_LANE, AIN(10) + l * DM); continue; } r -= I_UP;
            if (r < I_DN) { transpose_item<0>(AIN(14) + (size_t)l * DFF * DM, DFF, DM, DM, (bf16_t*)(AWS + WS_WDN + l * SZ_WDN), scr, r, K_LANE); continue; } r -= I_DN;
            if (r < I_GT) { transpose_item<0>(AIN(16) + (size_t)l * DM * DM, DM, DM, DM, (bf16_t*)(AWS + WS_WGT + l * SZ_WGT), scr, r, K_LANE, AIN(15) + l * DM); continue; } r -= I_GT;
            transpose_item<0>(AIN(17) + (size_t)l * PLED * DM, PLED, DM, DM, (bf16_t*)(AWS + WS_WPJ + l * SZ_WPJ), scr, r, K_LANE);
        }
        { unsigned* rq = (unsigned*)P_RSQ; for (int i = bx * 512 + K_TID; i < 8 * T; i += G * 512) rq[i] = 0u; }
        const size_t n8 = (size_t)2 * T * PLED / 8; const float* pp_ = AIN(1); bf16_t* pb_ = P_PB;
        for (size_t i = (size_t)bx * 512 + K_TID; i < n8; i += (size_t)G * 512) {
            const f32x4 v0 = *(const f32x4*)(pp_ + 8 * i), v1 = *(const f32x4*)(pp_ + 8 * i + 4);
            u32x4 w; w.x = pk2(v0[0], v0[1]); w.y = pk2(v0[2], v0[3]); w.z = pk2(v1[0], v1[1]); w.w = pk2(v1[2], v1[3]);
            *(u32x4*)(pb_ + 8 * i) = w;
        }
    }

    auto layer = [&](const int l) __attribute__((always_inline)) {

        {
#ifndef SKIP_NORMFG
            int lane_l = K_LANE, gw_l = K_GW; asm volatile("" : "+v"(lane_l), "+s"(gw_l));
#ifdef PROBE_P0X2
            for (int rep_ = 0; rep_ < 2; ++rep_)
#endif
            if (l == 0) norm_phase<true, false>(AIN(0), AIN(2) + l * DM, P_HN, AIN(3) + (size_t)l * DM * INC, AIN(7) + l * 6, P_LOGF, gw_l, NGW, lane_l);
            else norm_phase<true, true>((const float*)P_HB, AIN(2) + l * DM, P_HN, AIN(3) + (size_t)l * DM * INC, AIN(7) + l * 6, P_LOGF, gw_l, NGW, lane_l);
#endif
            if (l == 0 && gridDim.x > 1000000u) grid.sync();
            GSYNC();
        }
        {
#ifndef SKIP_SCAN
            if (bx < 48) { int tid_l = K_TID, bh_l = bx; asm volatile("" : "+v"(tid_l), "+s"(bh_l)); scan_unit(P_LOGF, P_F2, bh_l, (LAS double*)lds, tid_l); }
#endif
#ifndef SKIP_QKV
            pg8::Gemm g{P_HN, (const bf16_t*)(AWS + WS_WIN + l * SZ_WIN), T, ZP, DM}; pg8::StaticOrder S; S.init(T, ZP, G, bx);
            pg8::EpiQKV E{P_Zb, AIN(4) + l * 6 * 64};
#ifdef PROBE_PLAINQKV
            { pg8::EpiPlain EP{P_Zb}; pg8::gemm_phase<pg8::EpiPlain, pg8::StaticOrder, true, true>(lds, g, S, EP, K_TID); }
#endif
            pg8::gemm_phase<pg8::EpiQKV, pg8::StaticOrder, true, true>(lds, g, S, E, K_TID);
#ifdef PROBE_QKV2
            pg8::gemm_phase<pg8::EpiQKV, pg8::StaticOrder, true, true>(lds, g, S, E, K_TID);
#endif
#endif
        }
        GSYNC();
        {
            int lane_l = K_LANE, tid_l = K_TID; asm volatile("" : "+v"(lane_l), "+v"(tid_l));
            const float* gq = AIN(4) + l * 6 * 64;
            float mg[6];
#pragma unroll
            for (int j = 0; j < 6; ++j) mg[j] = wave_max(fabsf(gq[j * 64 + lane_l]));
            const float* rel = AIN(8) + l * 6 * 257;
            float mr = 0.f;
            for (int i = lane_l; i < 6 * 257; i += 64) mr = fmaxf(mr, fabsf(rel[i]));
            mr = wave_max(mr);
            const float* lp = AIN(5) + l * 4 * 64;
            const float s01 = wave_sum(lp[lane_l] * lp[64 + lane_l]), s23 = wave_sum(lp[128 + lane_l] * lp[192 + lane_l]);
            const float lam_init = (l == 0) ? 0.2f : (0.8f - 0.6f * 0.7408182206817179f);
            AttnCtx C;
            C.Z = P_Zb; C.O = P_HN; C.F2 = P_F2; C.rel = rel; C.subln = AIN(6) + l * 64;
            C.lam = expf(s01) - expf(s23) + lam_init; C.oml = 1.0f - lam_init;
            C.Mb0 = 8.0f * mg[0] * mg[1] * LOG2E * 1.02f + 1.0f; C.Mb1 = 8.0f * mg[2] * mg[3] * LOG2E * 1.02f + 1.0f; C.Mb2 = 8.0f * mg[4] * mg[5] * LOG2E * 1.02f + 1.0f + mr * LOG2E;
#ifndef SKIP_ATTN
            #define RFL(x) __uint_as_float(__builtin_amdgcn_readfirstlane(__float_as_uint(x)))
            C.lam = RFL(C.lam); C.oml = RFL(C.oml); C.Mb0 = RFL(C.Mb0); C.Mb1 = RFL(C.Mb1); C.Mb2 = RFL(C.Mb2);
            attn_phase(C, (unsigned*)(AWS + WS_CTL) + CTL_Q + 16 * (1 + l), lds, tid_l);
#ifdef PROBE_ATTN2
            attn_phase(C, (unsigned*)(AWS + WS_CTL) + CTL_Q + 16 * (1 + l) + 8, lds, tid_l);
#endif
#endif
        }
        GSYNC();
        {
            pg8::Gemm g{P_HN, (const bf16_t*)(AWS + WS_WOUT + l * SZ_WOUT), T, DM, DM}; pg8::StaticOrder S; S.init(T, DM, G, bx);
            pg8::EpiResid E{(l == 0) ? AIN(0) : (const float*)nullptr, P_HB, P_RSQ + (size_t)(2 * l) * T};
            pg8::gemm_phase<pg8::EpiResid, pg8::StaticOrder, true, true>(lds, g, S, E, K_TID);
        }
        GSYNC();
        {
            pg8::Gemm g{P_HB, (const bf16_t*)(AWS + WS_WUP + l * SZ_WUP), T, UPN, DM}; pg8::StaticOrder S; S.init(T, UPN, G, bx);
            pg8::EpiUp E{P_Zb, AIN(12) + (size_t)l * 3 * UPN, AIN(13) + l * UPN, P_EDGE, (LAS float*)(lds + LDS_XCH), P_RSQ + (size_t)(2 * l) * T, (LAS float*)(lds + LDS_PRM), (LAS float*)(lds + LDS_RSD)};
#ifndef SKIP_UP
            pg8::gemm_phase<pg8::EpiUp, pg8::StaticOrder, true, true>(lds, g, S, E, K_TID);
#ifdef PROBE_UP2
            pg8::gemm_phase<pg8::EpiUp, pg8::StaticOrder, true, true>(lds, g, S, E, K_TID);
#endif
#endif
        }
        GSYNC();
        {
            pg8::Gemm g{P_Zb, (const bf16_t*)(AWS + WS_WDN + l * SZ_WDN), T, DM, DFF}; pg8::StaticOrder S; S.init(T, DM, G, bx);
            pg8::Unit u;
            int tid_l = K_TID; asm volatile("" : "+v"(tid_l));
            for (int i = 0; S.next(i, u); ++i) fix_rows(P_Zb, P_EDGE, AIN(12) + (size_t)l * 3 * UPN, AIN(13) + l * UPN, u.pm, tid_l);
            __threadfence();
            __syncthreads();
            pg8::EpiResid E{nullptr, P_HB, P_RSQ + (size_t)(2 * l + 1) * T};
            pg8::gemm_phase<pg8::EpiResid, pg8::StaticOrder, true, true>(lds, g, S, E, K_TID);
        }
        GSYNC();
        {
            bf16_t* SG = P_Zb;
            pg8::StaticOrder S; S.init(T, DM, G, bx);
            { pg8::Gemm g{P_HB, (const bf16_t*)(AWS + WS_WGT + l * SZ_WGT), T, DM, DM}; pg8::EpiSig E{SG, P_RSQ + (size_t)(2 * l + 1) * T};
              pg8::gemm_phase<pg8::EpiSig, pg8::StaticOrder, true, true>(lds, g, S, E, K_TID);
#ifdef PROBE_SIG2
              pg8::gemm_phase<pg8::EpiSig, pg8::StaticOrder, true, true>(lds, g, S, E, K_TID);
#endif
            }
            GSYNC();
            { int kple = PLED; asm volatile("" : "+s"(kple));
              pg8::Gemm g{P_PB + (size_t)l * T * PLED, (const bf16_t*)(AWS + WS_WPJ + l * SZ_WPJ), T, DM, kple}; pg8::EpiMulAdd E{SG, P_HB, (l == 1) ? AOUT : (float*)nullptr};
              pg8::gemm_phase<pg8::EpiMulAdd, pg8::StaticOrder, true, true>(lds, g, S, E, K_TID); }
        }
        if (l == 0) GSYNC();
    };
    layer(0);
    layer(1);
}

extern "C" void kernel_launch(void* const* d_in, const int* in_sizes, int n_in, void* d_out, int out_size, void* d_ws, size_t ws_size, hipStream_t stream) {
    static int grid_blocks = 0;
    if (!grid_blocks) {
        int dev = 0, cus = 0, per_cu = 0;
        hipGetDevice(&dev);
        hipDeviceGetAttribute(&cus, hipDeviceAttributeMultiprocessorCount, dev);
        hipOccupancyMaxActiveBlocksPerMultiprocessor(&per_cu, fwd_megakernel, 512, 0);
        if (per_cu < 1) per_cu = 1;
        if (cus < 1) cus = 256;
        grid_blocks = cus * 1;
        if (n_in != 18 || ws_size < WS_END) fprintf(stderr, "kernel_launch: unexpected n_in %d or ws_size %zu (< %zu)\n", n_in, ws_size, (size_t)WS_END);
    }
    hipMemsetAsync(d_ws, 0, 16384, stream);
    Args a{};
    for (int i = 0; i < 18; ++i) a.in[i] = (const float*)d_in[i];
    a.out = (float*)d_out; a.ws = (unsigned char*)d_ws;
    void* args[] = {&a};
    hipError_t e = hipLaunchCooperativeKernel((void*)fwd_megakernel, dim3(grid_blocks), dim3(512), args, 0, stream);
    if (e != hipSuccess) fprintf(stderr, "cooperative launch failed: %s (grid %d)\n", hipGetErrorString(e), grid_blocks);
}
```

```cpp
#include <hip/hip_runtime.h>
#include <hip/hip_cooperative_groups.h>
#include <cstdio>
#include <cstdint>
namespace cg = cooperative_groups;

#define LAS __attribute__((address_space(3)))
typedef unsigned short bf16_t;
typedef short bf16x8 __attribute__((ext_vector_type(8)));
typedef short s16x4 __attribute__((ext_vector_type(4)));
typedef float f32x4 __attribute__((ext_vector_type(4)));
typedef float f32x16 __attribute__((ext_vector_type(16)));
typedef unsigned u32x4 __attribute__((ext_vector_type(4)));
typedef unsigned u32x2 __attribute__((ext_vector_type(2)));
typedef float f32x2_t __attribute__((ext_vector_type(2)));
typedef __bf16 bf16x2_t __attribute__((ext_vector_type(2)));

constexpr int NB = 8, SEQ = 4096, T = NB * SEQ, DM = 1024, ZP = 3584, DFF = 2816, UPN = 5632, PLED = 256, INC = 3590;
constexpr float EPS = 1e-6f, LOG2E = 1.4426950408889634f, C2 = 0.125f * 1.4426950408889634f;

constexpr size_t WS_CTL = 0;
constexpr size_t SZ_WIN = (size_t)ZP * DM * 2, SZ_WOUT = (size_t)DM * DM * 2, SZ_WUP = (size_t)UPN * DM * 2, SZ_WDN = (size_t)DM * DFF * 2, SZ_WGT = (size_t)DM * DM * 2, SZ_WPJ = (size_t)DM * PLED * 2;
constexpr size_t SZ_PB = (size_t)T * PLED * 2, SZ_HN = (size_t)T * DM * 2, SZ_Z = (size_t)T * ZP * 2, SZ_LOGF = (size_t)T * 6 * 4, SZ_EDGE = (size_t)128 * 22 * 1024 * 4;
constexpr size_t WS_WIN = 16384;
constexpr int CTL_Q = 3584;
constexpr size_t WS_WOUT = WS_WIN + 2 * SZ_WIN;
constexpr size_t WS_WUP = WS_WOUT + 2 * SZ_WOUT;
constexpr size_t WS_WDN = WS_WUP + 2 * SZ_WUP;
constexpr size_t WS_WGT = WS_WDN + 2 * SZ_WDN;
constexpr size_t WS_WPJ = WS_WGT + 2 * SZ_WGT;
constexpr size_t WS_PB = WS_WPJ + 2 * SZ_WPJ;
constexpr size_t WS_HN = WS_PB + 2 * SZ_PB;
constexpr size_t WS_Z = WS_HN + SZ_HN;
constexpr size_t WS_LOGF = WS_Z + SZ_Z;
constexpr size_t WS_F2 = WS_LOGF + SZ_LOGF;
constexpr size_t WS_EDGE = WS_F2 + SZ_LOGF;
constexpr size_t WS_HB = WS_EDGE + SZ_EDGE;
constexpr size_t WS_RSQ = WS_HB + SZ_HN;
constexpr size_t SZ_RSQ = (size_t)4 * T * 8;
constexpr size_t WS_END = WS_RSQ + SZ_RSQ;

__device__ __forceinline__ unsigned pk2(float lo, float hi) { f32x2_t v = {lo, hi}; bf16x2_t b = __builtin_convertvector(v, bf16x2_t); return __builtin_bit_cast(unsigned, b); }
#define DPPF(v, ctrl) __builtin_bit_cast(float, __builtin_amdgcn_update_dpp(0, __builtin_bit_cast(int, (v)), (ctrl), 0xf, 0xf, false))
__device__ __forceinline__ float xor16_sum(float v) { const auto r = __builtin_amdgcn_permlane16_swap(__float_as_uint(v), __float_as_uint(v), false, false); return __uint_as_float(r[0]) + __uint_as_float(r[1]); }
__device__ __forceinline__ float xor32_sum(float v) { const auto r = __builtin_amdgcn_permlane32_swap(__float_as_uint(v), __float_as_uint(v), false, false); return __uint_as_float(r[0]) + __uint_as_float(r[1]); }
__device__ __forceinline__ float xor16_max(float v) { const auto r = __builtin_amdgcn_permlane16_swap(__float_as_uint(v), __float_as_uint(v), false, false); return fmaxf(__uint_as_float(r[0]), __uint_as_float(r[1])); }
__device__ __forceinline__ float xor32_max(float v) { const auto r = __builtin_amdgcn_permlane32_swap(__float_as_uint(v), __float_as_uint(v), false, false); return fmaxf(__uint_as_float(r[0]), __uint_as_float(r[1])); }
__device__ __forceinline__ float row16_sum(float v) { v += DPPF(v, 0xB1); v += DPPF(v, 0x4E); v += DPPF(v, 0x141); v += DPPF(v, 0x140); return v; }
__device__ __forceinline__ float wave_sum(float v) { return xor32_sum(xor16_sum(row16_sum(v))); }
__device__ __forceinline__ float wave_max(float v) {
    v = fmaxf(v, DPPF(v, 0xB1)); v = fmaxf(v, DPPF(v, 0x4E)); v = fmaxf(v, DPPF(v, 0x141)); v = fmaxf(v, DPPF(v, 0x140));
    return xor32_max(xor16_max(v));
}
__device__ __forceinline__ float fast_exp2(float x) { return __builtin_amdgcn_exp2f(x); }
__device__ __forceinline__ float fast_rcp(float x) { return __builtin_amdgcn_rcpf(x); }
__device__ __forceinline__ float fast_rsq(float x) { return __builtin_amdgcn_rsqf(x); }
typedef unsigned long long u64_t;
__device__ __forceinline__ float rsq_sum(const u64_t* rsq, int row) { return (float)rsq[row] * (1.0f / 16777216.0f); }
__device__ __forceinline__ float row_rstd(const u64_t* rsq, int row) { return fast_rsq(rsq_sum(rsq, row) * (1.0f / DM) + EPS); }
__device__ __forceinline__ float sigmoidf_(float v) { return fast_rcp(1.0f + fast_exp2(-v * LOG2E)); }
#define XB_TMO      128
#define XB_XCNT(j)  (256  + 64 * (j))
#define XB_XSUB(j)  (1280 + 64 * (j))
#define XB_XGEN(j)  (2304 + 64 * (j))
#define XB_TOP      3328
#define XB_TOPGEN   3392
#define XCD_BAR_WORDS 3456
#define XB_SPIN_CAP (1u << 18)
__device__ __forceinline__ unsigned xb_ld(unsigned* p)              { return __hip_atomic_load(p, __ATOMIC_RELAXED, __HIP_MEMORY_SCOPE_AGENT); }
__device__ __forceinline__ unsigned xb_add(unsigned* p, unsigned v) { return __hip_atomic_fetch_add(p, v, __ATOMIC_RELAXED, __HIP_MEMORY_SCOPE_AGENT); }
__device__ __forceinline__ unsigned xb_xcc_id() { return (unsigned)__builtin_amdgcn_s_getreg((3 << 11) | 20) & 0xFu; }
#define XB_SPIN(cond, bar) do { unsigned _sp = 0; while (cond) { __builtin_amdgcn_s_sleep(1); \
    if ((++_sp & 255u) == 0u) { if (xb_ld(&(bar)[XB_TMO])) break; if (_sp > XB_SPIN_CAP) { atomicAdd(&(bar)[XB_TMO], 1u); break; } } } } while (0)

struct XcdBarrier {
    unsigned* bar; unsigned x;
    volatile LAS unsigned* st;
};

__device__ __forceinline__ XcdBarrier xcd_barrier_post(unsigned* bar, volatile LAS unsigned* st) {
    XcdBarrier b; b.bar = bar; b.x = xb_xcc_id(); b.st = st;
    if (threadIdx.x == 0) (void)xb_add(&bar[XB_XCNT(b.x)], 1u);
    return b;
}
__device__ __forceinline__ void xcd_barrier_complete(unsigned* bar, unsigned x, unsigned& nloc, unsigned& nx) {
    const unsigned G = gridDim.x * gridDim.y * gridDim.z;
    unsigned sum, cnt, mine, sp = 0u;
    for (;;) {
        sum = 0u; cnt = 0u; mine = 0u;
#pragma unroll
        for (unsigned j = 0; j < 16; ++j) { const unsigned c = xb_ld(&bar[XB_XCNT(j)]); sum += c; cnt += (c > 0u) ? 1u : 0u; mine = (j == x) ? c : mine; }
        if (sum == G) break;
        __builtin_amdgcn_s_sleep(1);
        if ((++sp & 255u) == 0u) { if (xb_ld(&bar[XB_TMO])) break; if (sp > XB_SPIN_CAP) { atomicAdd(&bar[XB_TMO], 1u); break; } }
    }
    nloc = mine > 0u ? mine : 1u; nx = cnt > 0u ? cnt : 1u;
}

__device__ __forceinline__ void xcd_barrier(const XcdBarrier& b, const bool xb_is_leader) {
    asm volatile("s_waitcnt vmcnt(0)" ::: "memory");
    __syncthreads();
    if (xb_is_leader) {
        unsigned* bar = b.bar;
        __builtin_amdgcn_s_waitcnt(0);
        unsigned nloc = b.st[0], nx = b.st[1];
        if (nloc == 0u) { xcd_barrier_complete(bar, b.x, nloc, nx); b.st[0] = nloc; b.st[1] = nx; }
        const unsigned old = xb_add(&bar[XB_XSUB(b.x)], 1u);
        const unsigned gen = old / nloc;
        if (old + 1u == (gen + 1u) * nloc) {
            __builtin_amdgcn_fence(__ATOMIC_RELEASE, "agent");
            asm volatile("s_waitcnt vmcnt(0)" ::: "memory");
            const unsigned og = xb_add(&bar[XB_TOP], 1u);
            const unsigned tg = og / nx;
            if (og + 1u == (tg + 1u) * nx) xb_add(&bar[XB_TOPGEN], 1u);
            else XB_SPIN(xb_ld(&bar[XB_TOPGEN]) == tg, bar);
            __builtin_amdgcn_fence(__ATOMIC_ACQUIRE, "agent");
            xb_add(&bar[XB_XGEN(b.x)], 1u);
            asm volatile("s_waitcnt vmcnt(0)" ::: "memory");
        } else {
            XB_SPIN(xb_ld(&bar[XB_XGEN(b.x)]) == gen, bar);
            __builtin_amdgcn_fence(__ATOMIC_ACQUIRE, "agent");
            asm volatile("s_waitcnt vmcnt(0)" ::: "memory");
        }
    }
    __syncthreads();
}
namespace pg8 {
#define PG8_LAS __attribute__((address_space(3)))
typedef unsigned short bf16_t;
typedef short bf16x8 __attribute__((ext_vector_type(8)));
typedef float f32x4 __attribute__((ext_vector_type(4)));
typedef unsigned u32x4 __attribute__((ext_vector_type(4)));
constexpr int BM = 256, BK = 64, HALF = 128, HTB = HALF * BK * 2  , STAGE_BYTES = 8 * HTB, NXCD = 8, WGM = 8;

__host__ __device__ __forceinline__ int lds_byte(int r, int c) { const int st = (r >> 4) * 2 + (c >> 5), rr = r & 15, cc = c & 31, ob = rr * 64 + cc * 2; return st * 1024 + (ob ^ (((ob >> 9) & 1) << 5)); }
__host__ __device__ __forceinline__ void stage_rc(int b, int& R, int& C) { const int st = b / 1024, sb = b % 1024, swz = sb ^ (((sb >> 9) & 1) << 5); R = (st >> 1) * 16 + swz / 64; C = (st & 1) * 32 + (swz % 64) / 2; }
__host__ __device__ __forceinline__ int perm32(int rho) { const int n = rho >> 4, i = rho & 15; return 8 * (i >> 2) + 4 * n + (i & 3); }

struct Unit { int pm, pn; };
struct Gemm { const bf16_t* A; const bf16_t* Bt; int M, N, K; };

struct StaticOrder {
    int nM, nN, nwg, G, c;
    __host__ __device__ void init(int M, int N, int G_, int c_) { nM = M / BM; nN = N / BM; nwg = nM * nN; G = G_; c = c_; }
    __host__ __device__ bool next(int i, Unit& u) const {
        const long L = (long)i * G + c; if (L >= nwg) return false;
        int wgid = (int)L; { const int q = nwg / NXCD, r = nwg % NXCD, xcd = wgid % NXCD, off = wgid / NXCD; wgid = (xcd < r ? xcd * (q + 1) : r * (q + 1) + (xcd - r) * q) + off; }
        const int nig = WGM * nN, gid = wgid / nig, fm = gid * WGM, gsz = (nM - fm) < WGM ? (nM - fm) : WGM;
        u.pm = fm + ((wgid % nig) % gsz); u.pn = (wgid % nig) / gsz; return true;
    }
    __device__ __forceinline__ void a_ready(const Unit&) const {}
    __device__ __forceinline__ void done(const Unit&) const {}
};

#define BPERM(v, srclane) __builtin_bit_cast(float, __builtin_amdgcn_ds_bpermute((srclane) << 2, __builtin_bit_cast(int, (float)(v))))
#define PG8_EPI_BAR() do { asm volatile("s_waitcnt lgkmcnt(0)" ::: "memory"); __builtin_amdgcn_s_barrier(); asm volatile("" ::: "memory"); } while (0)

struct EpiQKV {
    static constexpr bool PERM = true, AFTER_DRAIN = false, WANTS_NEXT = false, PERMA = false;
    bf16_t* Z; const float* gain;
    __device__ __forceinline__ void operator()(const f32x4 (&acc)[2][2][4][2], const Unit& u, int wr, int wc, int fr_in, int fq_in) const {
        int fr = fr_in, fq = fq_in; asm volatile("" : "+v"(fr), "+v"(fq));
        const int G = 4 * u.pn + wc;
        int gi; float sc = 1.f;
        if (G < 8) { gi = 0; sc = C2; } else if (G < 16) gi = 1; else if (G < 20) gi = -1; else if (G < 26) { gi = 2; sc = C2; } else if (G < 32) gi = 3;
        else if (G < 38) gi = -1; else if (G < 44) { gi = 4; sc = C2; } else if (G < 50) gi = 5; else gi = -1;
        f32x4 g[2][2];
#pragma unroll
        for (int bj = 0; bj < 2; ++bj) { g[bj][0] = (f32x4){1.f, 1.f, 1.f, 1.f}; g[bj][1] = g[bj][0]; }
        if (gi >= 0) {
#pragma unroll
            for (int bj = 0; bj < 2; ++bj) { const float* gp = gain + gi * 64 + 32 * bj + 8 * fq; g[bj][0] = *(const f32x4*)gp * sc; g[bj][1] = *(const f32x4*)(gp + 4) * sc; }
        }
        bf16_t* zb = Z + (size_t)(u.pm * BM + wr * 64 + fr) * ZP + u.pn * BM + wc * 64 + 8 * fq;
#pragma unroll
        for (int ai = 0; ai < 2; ++ai)
#pragma unroll
            for (int m = 0; m < 4; ++m) {
                float rstd = 1.f;
                if (gi >= 0) {
                    float s = 0.f;
#pragma unroll
                    for (int bj = 0; bj < 2; ++bj) { const f32x4 x0 = acc[ai][bj][m][0], x1 = acc[ai][bj][m][1];
                        s += (x0[0] * x0[0] + x0[1] * x0[1]) + (x0[2] * x0[2] + x0[3] * x0[3]) + (x1[0] * x1[0] + x1[1] * x1[1]) + (x1[2] * x1[2] + x1[3] * x1[3]); }
                    s = xor32_sum(xor16_sum(s));
                    rstd = fast_rsq(s * (1.0f / 64.0f) + EPS);
                }
#pragma unroll
                for (int bj = 0; bj < 2; ++bj) {
                    const f32x4 v0 = acc[ai][bj][m][0] * g[bj][0] * rstd, v1 = acc[ai][bj][m][1] * g[bj][1] * rstd;
                    u32x4 w; w.x = pk2(v0[0], v0[1]); w.y = pk2(v0[2], v0[3]); w.z = pk2(v1[0], v1[1]); w.w = pk2(v1[2], v1[3]);
                    *(u32x4*)(zb + (size_t)(ai * 128 + m * 16) * ZP + 32 * bj) = w;
                }
            }
    }
};

struct EpiPlain {
    static constexpr bool PERM = true, AFTER_DRAIN = false, WANTS_NEXT = false, PERMA = false;
    bf16_t* Z;
    __device__ __forceinline__ void operator()(const f32x4 (&acc)[2][2][4][2], const Unit& u, int wr, int wc, int fr_in, int fq_in) const {
        int fr = fr_in, fq = fq_in; asm volatile("" : "+v"(fr), "+v"(fq));
#pragma unroll
        for (int ai = 0; ai < 2; ++ai)
#pragma unroll
            for (int m = 0; m < 4; ++m)
#pragma unroll
                for (int bj = 0; bj < 2; ++bj) {
                    const f32x4 v0 = acc[ai][bj][m][0], v1 = acc[ai][bj][m][1];
                    u32x4 w; w.x = pk2(v0[0], v0[1]); w.y = pk2(v0[2], v0[3]); w.z = pk2(v1[0], v1[1]); w.w = pk2(v1[2], v1[3]);
                    *(u32x4*)(Z + (size_t)(u.pm * BM + ai * 128 + wr * 64 + m * 16 + fr) * ZP + u.pn * BM + bj * HALF + wc * 32 + 8 * fq) = w;
                }
    }
};

#define BF16_LO(w) __uint_as_float((w) << 16)
#define BF16_HI(w) __uint_as_float((w) & 0xffff0000u)
struct EpiResid {
    static constexpr bool PERM = true, AFTER_DRAIN = false, WANTS_NEXT = false, PERMA = false;
    const float* xbase; bf16_t* hb; u64_t* rsq;
    __device__ __forceinline__ void operator()(const f32x4 (&acc)[2][2][4][2], const Unit& u, int wr, int wc, int fr_in, int fq_in) const {
        int fr = fr_in, fq = fq_in; asm volatile("" : "+v"(fr), "+v"(fq));
#pragma unroll
        for (int ai = 0; ai < 2; ++ai)
#pragma unroll
            for (int m = 0; m < 4; ++m) {
                const int row = u.pm * BM + ai * 128 + wr * 64 + m * 16 + fr;
                float s = 0.f;
#pragma unroll
                for (int bj = 0; bj < 2; ++bj) {
                    const size_t off = (size_t)row * DM + u.pn * BM + bj * HALF + wc * 32 + 8 * fq;
                    f32x4 b0, b1;
                    if (xbase) { b0 = *(const f32x4*)(xbase + off); b1 = *(const f32x4*)(xbase + off + 4); }
                    else { const u32x4 q = *(const u32x4*)(hb + off);
                        b0 = (f32x4){BF16_LO(q.x), BF16_HI(q.x), BF16_LO(q.y), BF16_HI(q.y)}; b1 = (f32x4){BF16_LO(q.z), BF16_HI(q.z), BF16_LO(q.w), BF16_HI(q.w)}; }
                    const f32x4 h0 = b0 + acc[ai][bj][m][0], h1 = b1 + acc[ai][bj][m][1];
                    u32x4 w; w.x = pk2(h0[0], h0[1]); w.y = pk2(h0[2], h0[3]); w.z = pk2(h1[0], h1[1]); w.w = pk2(h1[2], h1[3]);
                    *(u32x4*)(hb + off) = w;
                    s += (h0[0] * h0[0] + h0[1] * h0[1]) + (h0[2] * h0[2] + h0[3] * h0[3]) + (h1[0] * h1[0] + h1[1] * h1[1]) + (h1[2] * h1[2] + h1[3] * h1[3]);
                }
                s = xor32_sum(xor16_sum(s));
                if (fq == 0) atomicAdd(rsq + row, (u64_t)(s * 16777216.0f));
                if (m == 3) asm volatile("" ::: "memory");
            }
    }
};

struct EpiSig {
    static constexpr bool PERM = true, AFTER_DRAIN = false, WANTS_NEXT = false, PERMA = false;
    bf16_t* SG; const u64_t* rsq;
    __device__ __forceinline__ void operator()(const f32x4 (&acc)[2][2][4][2], const Unit& u, int wr, int wc, int fr_in, int fq_in) const {
        int fr = fr_in, fq = fq_in; asm volatile("" : "+v"(fr), "+v"(fq));
#pragma unroll
        for (int ai = 0; ai < 2; ++ai)
#pragma unroll
            for (int m = 0; m < 4; ++m) {
                const int row = u.pm * BM + ai * 128 + wr * 64 + m * 16 + fr;
                const float rs = row_rstd(rsq, row);
#pragma unroll
                for (int bj = 0; bj < 2; ++bj) {
                    const size_t off = (size_t)row * DM + u.pn * BM + bj * HALF + wc * 32 + 8 * fq;
                    const f32x4 a = acc[ai][bj][m][0] * rs, b = acc[ai][bj][m][1] * rs;
                    u32x4 w; w.x = pk2(sigmoidf_(a[0]), sigmoidf_(a[1])); w.y = pk2(sigmoidf_(a[2]), sigmoidf_(a[3]));
                    w.z = pk2(sigmoidf_(b[0]), sigmoidf_(b[1])); w.w = pk2(sigmoidf_(b[2]), sigmoidf_(b[3]));
                    *(u32x4*)(SG + off) = w;
                }
                asm volatile("" ::: "memory");
            }
    }
};

struct EpiMulAdd {
    static constexpr bool PERM = true, AFTER_DRAIN = false, WANTS_NEXT = false, PERMA = false;
    const bf16_t* SG; bf16_t* hb; float* outf;
    __device__ __forceinline__ void operator()(const f32x4 (&acc)[2][2][4][2], const Unit& u, int wr, int wc, int fr_in, int fq_in) const {
        int fr = fr_in, fq = fq_in; asm volatile("" : "+v"(fr), "+v"(fq));
#pragma unroll
        for (int ai = 0; ai < 2; ++ai)
#pragma unroll
            for (int m = 0; m < 4; ++m)
#pragma unroll
                for (int bj = 0; bj < 2; ++bj) {
                    const size_t off = (size_t)(u.pm * BM + ai * 128 + wr * 64 + m * 16 + fr) * DM + u.pn * BM + bj * HALF + wc * 32 + 8 * fq;
                    const u32x4 s = *(const u32x4*)(SG + off), q = *(const u32x4*)(hb + off);
                    const f32x4 s0 = {BF16_LO(s.x), BF16_HI(s.x), BF16_LO(s.y), BF16_HI(s.y)}, s1 = {BF16_LO(s.z), BF16_HI(s.z), BF16_LO(s.w), BF16_HI(s.w)};
                    const f32x4 b0 = {BF16_LO(q.x), BF16_HI(q.x), BF16_LO(q.y), BF16_HI(q.y)}, b1 = {BF16_LO(q.z), BF16_HI(q.z), BF16_LO(q.w), BF16_HI(q.w)};
                    const f32x4 h0 = b0 + acc[ai][bj][m][0] * s0, h1 = b1 + acc[ai][bj][m][1] * s1;
                    if (outf) { *(f32x4*)(outf + off) = h0; *(f32x4*)(outf + off + 4) = h1; }
                    else { u32x4 w; w.x = pk2(h0[0], h0[1]); w.y = pk2(h0[2], h0[3]); w.z = pk2(h1[0], h1[1]); w.w = pk2(h1[2], h1[3]); *(u32x4*)(hb + off) = w; }
                    if (bj == 1 && (m & 1)) asm volatile("" ::: "memory");
                }
    }
};

struct EpiUp {
    static constexpr bool PERM = false, AFTER_DRAIN = false, WANTS_NEXT = true, PERMA = true;
    bf16_t* A; const float* cw; const float* cb; float* edge; PG8_LAS float* xr; const u64_t* rsq; PG8_LAS float* prm; PG8_LAS float* rsd;
    __device__ __forceinline__ float ldp(int j, int pn) const { const int gv = j >> 9, tap = (j >> 7) & 3, col = gv * DFF + 128 * pn + (j & 127); return tap < 3 ? cw[tap * UPN + col] : cb[col]; }
#define DPPO(oldv, v, ctrl) __builtin_bit_cast(float, __builtin_amdgcn_update_dpp(__builtin_bit_cast(int, (float)(oldv)), __builtin_bit_cast(int, (float)(v)), (ctrl), 0xf, 0xf, false))
    __device__ __forceinline__ void run(const f32x4 (&acc)[2][2][4][2], const Unit& u, const Unit& nxt, bool has_next, int ui, int wr, int wc, int fr_in, int fq_in) const {
        int fr = fr_in, fq = fq_in; asm volatile("" : "+v"(fr), "+v"(fq));
        const int tid = (wr * 4 + wc) * 64 + fq * 16 + fr;
        const int slot = ui & 1;
        if (ui == 0) {
            prm[slot * 1024 + tid] = ldp(tid, u.pn); prm[slot * 1024 + tid + 512] = ldp(tid + 512, u.pn);
            if (tid < 256) rsd[slot * 256 + tid] = row_rstd(rsq, u.pm * BM + tid);
            PG8_EPI_BAR();
        }
        float nx0 = 0.f, nx1 = 0.f, nrs = 1.f;
        if (has_next) { nx0 = ldp(tid, nxt.pn); nx1 = ldp(tid + 512, nxt.pn); if (tid < 256) nrs = rsq_sum(rsq, nxt.pm * BM + tid); }
        float* eg = edge + (size_t)(u.pm * 22 + u.pn) * 1024;
        float rs[2][4];
#pragma unroll
        for (int ai = 0; ai < 2; ++ai)
#pragma unroll
            for (int m = 0; m < 4; ++m) rs[ai][m] = rsd[slot * 256 + ai * 128 + wr * 64 + 4 * fr + m];
#pragma unroll
        for (int bj = 0; bj < 2; ++bj)
#pragma unroll
            for (int n = 0; n < 2; ++n) {
                const int colt = bj * 128 + wc * 32 + n * 16 + 4 * fq;
                if (fr == 15) {
                    *(PG8_LAS f32x4*)(xr + ((0 + wr) * 2 + 0) * 256 + colt) = acc[0][bj][2][n] * rs[0][2]; *(PG8_LAS f32x4*)(xr + ((0 + wr) * 2 + 1) * 256 + colt) = acc[0][bj][3][n] * rs[0][3];
                    *(PG8_LAS f32x4*)(xr + ((2 + wr) * 2 + 0) * 256 + colt) = acc[1][bj][2][n] * rs[1][2]; *(PG8_LAS f32x4*)(xr + ((2 + wr) * 2 + 1) * 256 + colt) = acc[1][bj][3][n] * rs[1][3];
                    if (wr == 1) { *(f32x4*)(eg + 2 * 256 + colt) = acc[1][bj][2][n] * rs[1][2]; *(f32x4*)(eg + 3 * 256 + colt) = acc[1][bj][3][n] * rs[1][3]; }
                }
                if (wr == 0 && fr == 0) { *(f32x4*)(eg + colt) = acc[0][bj][0][n] * rs[0][0]; *(f32x4*)(eg + 256 + colt) = acc[0][bj][1][n] * rs[0][1]; }
            }
        PG8_EPI_BAR();
#pragma unroll
        for (int ai = 0; ai < 2; ++ai)
#pragma unroll
            for (int m = 0; m < 4; ++m) asm volatile("" : "+v"(rs[ai][m]));
#pragma unroll
        for (int n = 0; n < 2; ++n) {
            const int cl = wc * 32 + n * 16 + 4 * fq, ch = u.pn * 128 + cl;
            const PG8_LAS float* pp = prm + slot * 1024 + cl;
            const f32x4 wg0 = *(const PG8_LAS f32x4*)(pp), wg1 = *(const PG8_LAS f32x4*)(pp + 128), wg2 = *(const PG8_LAS f32x4*)(pp + 256), bg = *(const PG8_LAS f32x4*)(pp + 384);
            const f32x4 wv0 = *(const PG8_LAS f32x4*)(pp + 512), wv1 = *(const PG8_LAS f32x4*)(pp + 640), wv2 = *(const PG8_LAS f32x4*)(pp + 768), bv = *(const PG8_LAS f32x4*)(pp + 896);
#pragma unroll
            for (int ai = 0; ai < 2; ++ai) {
                const int grp = 2 * ai + wr;
                f32x4 hg2 = {0.f, 0.f, 0.f, 0.f}, hg3 = hg2, hv2 = hg2, hv3 = hg2;
                if (grp > 0 && fr == 0) { const PG8_LAS float* xp = xr + ((grp - 1) * 2) * 256 + cl;
                    hg2 = *(const PG8_LAS f32x4*)(xp); hg3 = *(const PG8_LAS f32x4*)(xp + 256); hv2 = *(const PG8_LAS f32x4*)(xp + 128); hv3 = *(const PG8_LAS f32x4*)(xp + 256 + 128); }
                f32x4 pg2, pg1, pv2, pv1;
                {
                    const f32x4 g2 = acc[ai][0][2][n] * rs[ai][2], g3 = acc[ai][0][3][n] * rs[ai][3], v2 = acc[ai][1][2][n] * rs[ai][2], v3 = acc[ai][1][3][n] * rs[ai][3];
#pragma unroll
                    for (int i = 0; i < 4; ++i) {
                        float a0 = g2[i], a1 = g3[i], a2 = v2[i], a3 = v3[i];
                        asm volatile("" : "+v"(a0), "+v"(a1), "+v"(a2), "+v"(a3));
                        const float t0 = DPPF(a0, 0x111), t1 = DPPF(a1, 0x111), t2 = DPPF(a2, 0x111), t3 = DPPF(a3, 0x111);
                        pg2[i] = t0 + hg2[i]; pg1[i] = t1 + hg3[i]; pv2[i] = t2 + hv2[i]; pv1[i] = t3 + hv3[i]; }
                }
#pragma unroll
                for (int m = 0; m < 4; ++m) {
                    const f32x4 gc = acc[ai][0][m][n] * rs[ai][m], vc = acc[ai][1][m][n] * rs[ai][m];
                    const f32x4 cgt = bg + wg0 * pg2 + wg1 * pg1 + wg2 * gc, cvl = bv + wv0 * pv2 + wv1 * pv1 + wv2 * vc;
                    float a[4];
#pragma unroll
                    for (int i = 0; i < 4; ++i) a[i] = cgt[i] * sigmoidf_(cgt[i]) * cvl[i];
                    u32x2 w; w.x = pk2(a[0], a[1]); w.y = pk2(a[2], a[3]);
                    *(u32x2*)(A + (size_t)(u.pm * BM + ai * 128 + wr * 64 + 4 * fr + m) * DFF + ch) = w;
                    pg2 = pg1; pg1 = gc; pv2 = pv1; pv1 = vc;
                }
                asm volatile("" ::: "memory");
            }
        }
        if (has_next) {
            prm[(slot ^ 1) * 1024 + tid] = nx0; prm[(slot ^ 1) * 1024 + tid + 512] = nx1;
            if (tid < 256) rsd[(slot ^ 1) * 256 + tid] = fast_rsq(nrs * (1.0f / DM) + EPS);
        }
    }
};
template <class Epi, class Sched, bool ALIGN_EPI = false, bool SP2 = false>
__device__ __forceinline__ void gemm_phase(PG8_LAS unsigned char* lds, const Gemm g, const Sched& S, const Epi& E, const int tid_arg) {
    int tid_l = tid_arg; asm volatile("" : "+v"(tid_l));
    const int tid = tid_l, wid = __builtin_amdgcn_readfirstlane(tid >> 6), lane = tid & 63, wr = wid >> 2, wc = wid & 3, fr = lane & 15, fq = lane >> 4;
    const int K = g.K, nt = K / BK;
    unsigned voffA[2], voffB[2];
#pragma unroll
    for (int i = 0; i < 2; ++i) { int R, C; stage_rc(tid * 16 + i * 8192, R, C); const int Rb = Epi::PERM ? ((R & ~31) + perm32(R & 31)) : R;
        const int Ra = Epi::PERMA ? ((R & ~63) + 4 * (R & 15) + ((R >> 4) & 3)) : R;
        voffA[i] = (unsigned)(Ra * K + C) * 2u; voffB[i] = (unsigned)(Rb * K + C) * 2u; }
    const size_t kstep = (size_t)(BK * 2);
    const size_t hstep = (size_t)HALF * K * 2;
    const size_t tstep = 2 * hstep;
    const unsigned ldsw = (unsigned)wid * 1024u;
    const int aoff = lds_byte(wr * 64 + fr, fq * 8), boff = lds_byte(wc * 32 + fr, fq * 8);
#define PG8_SA(b, h) (((b) * 2 + (h)) * HTB)
#define PG8_SB(b, h) ((4 + (b) * 2 + (h)) * HTB)
#define PG8_STAGE(bufoff, gbase, voff) do { _Pragma("unroll") for (int _i = 0; _i < 2; ++_i) \
        __builtin_amdgcn_global_load_lds((const unsigned*)((const char*)(gbase) + (voff)[_i]), (PG8_LAS unsigned*)(lds + (bufoff) + ldsw + _i * 8192), 16, 0, 0); } while (0)
#define PG8_LDA(dst, b, h) do { _Pragma("unroll") for (int m = 0; m < 4; ++m) _Pragma("unroll") for (int k = 0; k < 2; ++k) dst[m][k] = *(const PG8_LAS bf16x8*)(lds + PG8_SA(b, h) + aoff + m * 2048 + k * 1024); } while (0)
#define PG8_LDB(dst, b, h) do { _Pragma("unroll") for (int n = 0; n < 2; ++n) _Pragma("unroll") for (int k = 0; k < 2; ++k) dst[n][k] = *(const PG8_LAS bf16x8*)(lds + PG8_SB(b, h) + boff + n * 2048 + k * 1024); } while (0)
#define PG8_MMA(ai, bj, At, Bt) do { __builtin_amdgcn_s_setprio(1); _Pragma("unroll") for (int m = 0; m < 4; ++m) _Pragma("unroll") for (int n = 0; n < 2; ++n) _Pragma("unroll") for (int k = 0; k < 2; ++k) \
        acc[ai][bj][m][n] = __builtin_amdgcn_mfma_f32_16x16x32_bf16(Bt[n][k], At[m][k], acc[ai][bj][m][n], 0, 0, 0); __builtin_amdgcn_s_setprio(0); } while (0)
#define PG8_WAIT_V(n) asm volatile("s_waitcnt vmcnt(" #n ")" ::: "memory")
#define PG8_WAIT_L(n) asm volatile("s_waitcnt lgkmcnt(" #n ")" ::: "memory")
#define PG8_BAR __builtin_amdgcn_s_barrier()
#define PG8_SCHED __builtin_amdgcn_sched_barrier(0)
    Unit cur, nxt; int ui = 0;
    if (!S.next(0, cur)) return;
    f32x4 acc[2][2][4][2];
#pragma unroll
    for (int a = 0; a < 2; ++a)
#pragma unroll
        for (int b = 0; b < 2; ++b)
#pragma unroll
            for (int m = 0; m < 4; ++m)
#pragma unroll
                for (int n = 0; n < 2; ++n) acc[a][b][m][n] = (f32x4){0.f, 0.f, 0.f, 0.f};
    bf16x8 At[4][2], B0[2][2], B1[2][2];
    const char* cA = (const char*)g.A + (size_t)cur.pm * tstep; const char* cB = (const char*)g.Bt + (size_t)cur.pn * tstep;
    S.a_ready(cur);
    if constexpr (SP2) {
        PG8_STAGE(PG8_SB(0, 0), cB, voffB); PG8_STAGE(PG8_SB(0, 1), cB + hstep, voffB); PG8_STAGE(PG8_SA(0, 0), cA, voffA); PG8_STAGE(PG8_SA(0, 1), cA + hstep, voffA);
        if (wr == 1) PG8_BAR;
        PG8_WAIT_V(2); PG8_BAR;
        PG8_STAGE(PG8_SB(1, 0), cB + kstep, voffB); PG8_STAGE(PG8_SA(1, 0), cA + kstep, voffA); PG8_STAGE(PG8_SB(1, 1), cB + hstep + kstep, voffB);
        PG8_WAIT_V(6); PG8_BAR;
    } else {
        PG8_STAGE(PG8_SB(0, 0), cB, voffB); PG8_STAGE(PG8_SA(0, 0), cA, voffA); PG8_STAGE(PG8_SB(0, 1), cB + hstep, voffB); PG8_STAGE(PG8_SA(0, 1), cA + hstep, voffA);
        if (wr == 1) PG8_BAR;
        PG8_WAIT_V(4); PG8_BAR;
        PG8_STAGE(PG8_SB(1, 0), cB + kstep, voffB); PG8_STAGE(PG8_SA(1, 0), cA + kstep, voffA); PG8_STAGE(PG8_SB(1, 1), cB + hstep + kstep, voffB);
        PG8_WAIT_V(6); PG8_BAR;
    }
    for (;;) {
        const bool has_next = S.next(ui + 1, nxt);
        const char* nA = has_next ? (const char*)g.A + (size_t)nxt.pm * tstep : cA; const char* nB = has_next ? (const char*)g.Bt + (size_t)nxt.pn * tstep : cB;
        for (int t = 0; t < nt; t += 2) {
            const bool last = (t == nt - 2);
            const char* a1 = cA + (size_t)(t + 1) * kstep;
            const char* a2 = last ? nA : cA + (size_t)(t + 2) * kstep; const char* b2 = last ? nB : cB + (size_t)(t + 2) * kstep;
            const char* a3 = a2 + kstep; const char* b3 = b2 + kstep;
            if (last && has_next) S.a_ready(nxt);
            if constexpr (SP2) {
            PG8_LDB(B0, 0, 0); PG8_LDB(B1, 0, 1); PG8_SCHED; PG8_LDA(At, 0, 0); PG8_STAGE(PG8_SA(1, 1), a1 + hstep, voffA);
            PG8_WAIT_V(8); PG8_WAIT_L(0); PG8_BAR; PG8_MMA(0, 0, At, B0); PG8_MMA(0, 1, At, B1); PG8_BAR; PG8_SCHED;
            PG8_LDA(At, 0, 1); PG8_STAGE(PG8_SB(0, 0), b2, voffB); PG8_STAGE(PG8_SB(0, 1), b2 + hstep, voffB); PG8_STAGE(PG8_SA(0, 0), a2, voffA);
            PG8_WAIT_V(8); PG8_WAIT_L(0); PG8_BAR; PG8_MMA(1, 0, At, B0); PG8_MMA(1, 1, At, B1); PG8_BAR; PG8_SCHED;
            PG8_LDB(B0, 1, 0); PG8_LDB(B1, 1, 1); PG8_SCHED; PG8_LDA(At, 1, 0); PG8_STAGE(PG8_SA(0, 1), a2 + hstep, voffA);
            PG8_WAIT_V(8); PG8_WAIT_L(0); PG8_BAR; PG8_MMA(0, 0, At, B0); PG8_MMA(0, 1, At, B1); PG8_BAR; PG8_SCHED;
            PG8_LDA(At, 1, 1); PG8_STAGE(PG8_SB(1, 0), b3, voffB); PG8_STAGE(PG8_SB(1, 1), b3 + hstep, voffB); PG8_STAGE(PG8_SA(1, 0), a3, voffA);
            PG8_WAIT_V(8); PG8_WAIT_L(0); PG8_BAR; PG8_MMA(1, 0, At, B0); PG8_MMA(1, 1, At, B1); PG8_BAR; PG8_SCHED;
            } else {
            PG8_LDB(B0, 0, 0); PG8_SCHED; PG8_LDA(At, 0, 0); PG8_STAGE(PG8_SA(1, 1), a1 + hstep, voffA);
            PG8_WAIT_L(8); PG8_BAR; PG8_WAIT_L(0); PG8_MMA(0, 0, At, B0); PG8_BAR; PG8_SCHED;
            PG8_LDB(B1, 0, 1); PG8_STAGE(PG8_SB(0, 0), b2, voffB);
            PG8_BAR; PG8_WAIT_L(0); PG8_MMA(0, 1, At, B1); PG8_BAR;
            PG8_LDA(At, 0, 1); PG8_STAGE(PG8_SA(0, 0), a2, voffA);
            PG8_BAR; PG8_WAIT_L(0); PG8_MMA(1, 0, At, B0); PG8_BAR; PG8_SCHED;
            PG8_STAGE(PG8_SB(0, 1), b2 + hstep, voffB);
            PG8_WAIT_V(6); PG8_BAR; PG8_MMA(1, 1, At, B1); PG8_BAR;
            PG8_LDB(B0, 1, 0); PG8_SCHED; PG8_LDA(At, 1, 0); PG8_STAGE(PG8_SA(0, 1), a2 + hstep, voffA);
            PG8_WAIT_L(8); PG8_BAR; PG8_WAIT_L(0); PG8_MMA(0, 0, At, B0); PG8_BAR; PG8_SCHED;
            PG8_LDB(B1, 1, 1); PG8_STAGE(PG8_SB(1, 0), b3, voffB);
            PG8_BAR; PG8_WAIT_L(0); PG8_MMA(0, 1, At, B1); PG8_BAR;
            PG8_LDA(At, 1, 1); PG8_STAGE(PG8_SA(1, 0), a3, voffA);
            PG8_BAR; PG8_WAIT_L(0); PG8_MMA(1, 0, At, B0); PG8_BAR; PG8_SCHED;
            PG8_STAGE(PG8_SB(1, 1), b3 + hstep, voffB);
            PG8_WAIT_V(6); PG8_BAR; PG8_MMA(1, 1, At, B1); PG8_BAR;
            }
        }
        if constexpr (ALIGN_EPI) { if (wr == 0) PG8_BAR; }
        if constexpr (!Epi::AFTER_DRAIN) { if constexpr (Epi::WANTS_NEXT) E.run(acc, cur, nxt, has_next, ui, wr, wc, fr, fq); else E(acc, cur, wr, wc, fr, fq); S.done(cur); }
        if (!has_next) break;
#pragma unroll
        for (int a = 0; a < 2; ++a)
#pragma unroll
            for (int b = 0; b < 2; ++b)
#pragma unroll
                for (int m = 0; m < 4; ++m)
#pragma unroll
                    for (int n = 0; n < 2; ++n) acc[a][b][m][n] = (f32x4){0.f, 0.f, 0.f, 0.f};
        cur = nxt; cA = nA; cB = nB; ++ui;
        if constexpr (ALIGN_EPI) { if (wr == 1) PG8_BAR; }
    }
    PG8_WAIT_V(0);
    if constexpr (!ALIGN_EPI) { if (wr == 0) PG8_BAR; }
    PG8_BAR;
    if constexpr (Epi::AFTER_DRAIN) { E.fused(acc, cur, wr, wc, fr, fq, lds, wid, lane); S.done(cur); }
#undef PG8_SA
#undef PG8_SB
#undef PG8_STAGE
#undef PG8_LDA
#undef PG8_LDB
#undef PG8_MMA
#undef PG8_WAIT_V
#undef PG8_WAIT_L
#undef PG8_BAR
#undef PG8_SCHED
}
}
template <int MODE> __device__ __forceinline__ int srccol(int n) {
    if (MODE == 1) {
        const int ct = n & 255, lg = (n & ~255) + ((ct >> 5) & 3) * 64 + (ct >> 7) * 32 + (ct & 31);
        return lg < 2432 ? lg : lg + 6; }
    if (MODE == 2) { const int pn = n >> 8, j = n & 255; return j < 128 ? 128 * pn + j : DFF + 128 * pn + (j - 128); }
    return n;
}
template <int MODE> __device__ __forceinline__ void transpose_item(const float* W, int K, int Nsrc, int Ndst, bf16_t* WT, LAS float* scr, int item, int lane, const float* kgain = nullptr) {
    const int nblk = Ndst / 32, kb = item / nblk, nb = item % nblk, k0 = 64 * kb, n0 = 32 * nb;
    const int sc = srccol<MODE>(n0 + (lane & 31));
#pragma unroll
    for (int i = 0; i < 32; ++i) { const int kk = 2 * i + (lane >> 5); scr[kk * 33 + (lane & 31)] = W[(size_t)(k0 + kk) * Nsrc + sc] * (kgain ? kgain[k0 + kk] : 1.0f); }
    asm volatile("s_waitcnt lgkmcnt(0)" ::: "memory");
    const int c = lane & 7;
#pragma unroll
    for (int j = 0; j < 4; ++j) { const int n = (lane >> 3) + 8 * j; const LAS float* s = scr + (8 * c) * 33 + n;
        u32x4 o; o.x = pk2(s[0 * 33], s[1 * 33]); o.y = pk2(s[2 * 33], s[3 * 33]); o.z = pk2(s[4 * 33], s[5 * 33]); o.w = pk2(s[6 * 33], s[7 * 33]);
        *(u32x4*)(WT + (size_t)(n0 + n) * K + k0 + 8 * c) = o; }
    asm volatile("s_waitcnt lgkmcnt(0)" ::: "memory");
}

template <bool FG, bool BIN = false> __device__ __forceinline__ void norm_phase(const float* hin, const float* gain, bf16_t* out, const float* win, const float* fbias, float* logf, int gw, int NGW, int lane) {
    float g[16];
#pragma unroll
    for (int i = 0; i < 2; ++i) { const int c0 = 8 * (lane + 64 * i); const f32x4 a = *(const f32x4*)(gain + c0), b = *(const f32x4*)(gain + c0 + 4);
        g[8 * i + 0] = a[0]; g[8 * i + 1] = a[1]; g[8 * i + 2] = a[2]; g[8 * i + 3] = a[3]; g[8 * i + 4] = b[0]; g[8 * i + 5] = b[1]; g[8 * i + 6] = b[2]; g[8 * i + 7] = b[3]; }
    float wf[6][16]; float fb[6];
    if (FG) {
#pragma unroll
        for (int i = 0; i < 2; ++i)
#pragma unroll
            for (int e = 0; e < 8; ++e) { const float* wp = win + (size_t)(8 * (lane + 64 * i) + e) * INC + 2432;
#pragma unroll
                for (int j = 0; j < 6; ++j) wf[j][8 * i + e] = wp[j] * g[8 * i + e]; }
#pragma unroll
        for (int j = 0; j < 6; ++j) fb[j] = fbias[j];
    }
    f32x4 nx[4];
    const bf16_t* hbin = (const bf16_t*)hin;
#define NORM_LD(rowi) do { _Pragma("unroll") for (int i = 0; i < 2; ++i) { const int c0 = 8 * (lane + 64 * i); \
        if (BIN) { const u32x4 q_ = *(const u32x4*)(hbin + (size_t)(rowi) * DM + c0); \
            nx[2 * i] = (f32x4){__uint_as_float(q_.x << 16), __uint_as_float(q_.x & 0xffff0000u), __uint_as_float(q_.y << 16), __uint_as_float(q_.y & 0xffff0000u)}; \
            nx[2 * i + 1] = (f32x4){__uint_as_float(q_.z << 16), __uint_as_float(q_.z & 0xffff0000u), __uint_as_float(q_.w << 16), __uint_as_float(q_.w & 0xffff0000u)}; } \
        else { nx[2 * i] = *(const f32x4*)(hin + (size_t)(rowi) * DM + c0); nx[2 * i + 1] = *(const f32x4*)(hin + (size_t)(rowi) * DM + c0 + 4); } } } while (0)
    if (gw < T) NORM_LD(gw);
    for (int row = gw; row < T; row += NGW) {
        float x[16];
#pragma unroll
        for (int i = 0; i < 4; ++i) { x[4 * i + 0] = nx[i][0]; x[4 * i + 1] = nx[i][1]; x[4 * i + 2] = nx[i][2]; x[4 * i + 3] = nx[i][3]; }
        if (row + NGW < T) NORM_LD(row + NGW);
        float ss = 0.f;
#pragma unroll
        for (int e = 0; e < 16; ++e) ss += x[e] * x[e];
        ss = wave_sum(ss);
        const float rstd = fast_rsq(ss * (1.0f / DM) + EPS);
#pragma unroll
        for (int i = 0; i < 2; ++i) { u32x4 w;
            w.x = pk2(x[8 * i + 0] * rstd * g[8 * i + 0], x[8 * i + 1] * rstd * g[8 * i + 1]); w.y = pk2(x[8 * i + 2] * rstd * g[8 * i + 2], x[8 * i + 3] * rstd * g[8 * i + 3]);
            w.z = pk2(x[8 * i + 4] * rstd * g[8 * i + 4], x[8 * i + 5] * rstd * g[8 * i + 5]); w.w = pk2(x[8 * i + 6] * rstd * g[8 * i + 6], x[8 * i + 7] * rstd * g[8 * i + 7]);
            *(u32x4*)(out + (size_t)row * DM + 8 * (lane + 64 * i)) = w; }
        if (FG) {
            float mine = 0.f;
#pragma unroll
            for (int j = 0; j < 6; ++j) { float d = 0.f;
#pragma unroll
                for (int e = 0; e < 16; ++e) d += x[e] * wf[j][e];
                d = wave_sum(d) * rstd + fb[j];
                if (lane == j) mine = d; }
            if (lane < 6) { const float v = mine; logf[(size_t)row * 6 + lane] = fminf(v, 0.f) - log1pf(expf(-fabsf(v))); }
        }
    }
}

__device__ __forceinline__ void scan_unit(const float* logf, float* F2, int bh, LAS double* sd, int tid) {
    const int b = bh / 6, h = bh % 6;
    const float* src = logf + (size_t)b * SEQ * 6 + h;
    double loc[8]; double run = 0.0;
#pragma unroll
    for (int i = 0; i < 8; ++i) { run += (double)src[(size_t)(8 * tid + i) * 6]; loc[i] = run; }
    sd[tid] = run;
    __syncthreads();
    if (tid < 8) { double r = 0.0; for (int k = 0; k < 64; ++k) { const double v = sd[tid * 64 + k]; sd[tid * 64 + k] = r; r += v; } sd[512 + tid] = r; }
    __syncthreads();
    double off = sd[tid];
#pragma unroll
    for (int s = 0; s < 8; ++s) if (s < (tid >> 6)) off += sd[512 + s];
#pragma unroll
    for (int i = 0; i < 8; ++i) F2[(size_t)bh * SEQ + 8 * tid + i] = (float)((off + loc[i]) * 1.4426950408889634);
    __syncthreads();
}

__device__ __forceinline__ void fix_rows(bf16_t* A, const float* edge, const float* cw, const float* cb, int pm, int tid) {
    const bool hasprev = (pm & 15) != 0;
#pragma unroll
    for (int it_ = 0; it_ < 6; ++it_) {
        const int ch = tid + 512 * it_; if (ch >= DFF) break;
        const int pn = ch >> 7, ci = ch & 127;
        const float* E = edge + (size_t)(pm * 22 + pn) * 1024;
        const float* P = hasprev ? edge + (size_t)((pm - 1) * 22 + pn) * 1024 : E;
        float c0[2], c1[2];
#pragma unroll
        for (int gv = 0; gv < 2; ++gv) {
            const int col = gv * 128 + ci, cc = gv * DFF + ch;
            const float u0 = E[col], u1 = E[256 + col], p254 = hasprev ? P[512 + col] : 0.f, p255 = hasprev ? P[768 + col] : 0.f;
            const float w0 = cw[cc], w1 = cw[UPN + cc], w2 = cw[2 * UPN + cc], bb = cb[cc];
            c0[gv] = bb + w0 * p254 + w1 * p255 + w2 * u0; c1[gv] = bb + w0 * p255 + w1 * u0 + w2 * u1;
        }
        const float a0 = c0[0] * sigmoidf_(c0[0]) * c0[1], a1 = c1[0] * sigmoidf_(c1[0]) * c1[1];
        A[(size_t)(pm * 256) * DFF + ch] = (bf16_t)(pk2(a0, 0.f) & 0xffffu);
        A[(size_t)(pm * 256 + 1) * DFF + ch] = (bf16_t)(pk2(a1, 0.f) & 0xffffu);
    }
}

struct AttnCtx { const bf16_t* Z; bf16_t* O; const float* F2; const float* rel; const float* subln; float lam, oml, Mb0, Mb1, Mb2; };
__device__ __forceinline__ int crow(int r, int hi) { return (r & 3) + 8 * (r >> 2) + 4 * hi; }
#define MFMA32(a, b, c) __builtin_amdgcn_mfma_f32_32x32x16_bf16((a), (b), (c), 0, 0, 0)
typedef short v4i16_t __attribute__((ext_vector_type(4)));
__device__ __forceinline__ s16x4 vtr(const LAS unsigned char* p) { return __builtin_bit_cast(s16x4, __builtin_amdgcn_ds_read_tr16_b64_v4i16((LAS v4i16_t*)p)); }

constexpr int AL_K = 0, AL_V = 32768, AL_F = 65536, AL_REL = 66560, AL_WS = 68608, AL_U = 69632;

template <int TYPE> __device__ __forceinline__ void attn_unit(const AttnCtx& C, int b, int h, int qb, LAS unsigned char* lds, int tid_in, unsigned* counter) {
    int tid = tid_in; asm volatile("" : "+v"(tid));
    const int lane = tid & 63, w = __builtin_amdgcn_readfirstlane(tid >> 6), r32 = lane & 31, hi = lane >> 5;
    const int cq = 4 * qb + (w >> 1);
    const float sl2 = (TYPE == 0) ? exp2f(-2.0f * (float)(h + 1)) * LOG2E : 0.f;
    const float dmax = (TYPE == 0) ? (160.0f + C.Mb0) / sl2 : 0.f;
    int t0 = 0; const int t1 = 4 * qb + 4;
    if (TYPE == 2) t0 = (4 * qb - 8 > 0) ? 4 * qb - 8 : 0;
    if (TYPE == 0) { const float num = (float)(256 * qb - 63) - dmax; if (num >= 0.f) t0 = (int)(num * (1.0f / 64.0f)) + 1; }
    int tfirst = 0;
    if (TYPE == 1) {
        const float* f2t = C.F2 + (size_t)(b * 6 + h) * SEQ;
        const float fend = f2t[64 * lane + 63];
        const float fq_unit = f2t[256 * qb], fq_wave = f2t[256 * qb + 32 * w];
        const unsigned long long need_u = __ballot(fq_unit - fend > -160.0f), need_w = __ballot(fq_wave - fend > -160.0f);
        t0 = need_u ? (int)__builtin_ctzll(need_u) : 0; tfirst = need_w ? (int)__builtin_ctzll(need_w) : 0;
        if (t0 > 4 * qb) t0 = 4 * qb;
    }
    t0 &= ~1;
    const int sq = 256 * qb + 32 * w + r32;
    const size_t rowb = (size_t)b * SEQ;
    LAS unsigned char* Kb = lds + AL_K; LAS unsigned char* Vb = lds + AL_V;
    LAS float* Fb = (LAS float*)(lds + AL_F); LAS float* relb = (LAS float*)(lds + AL_REL); LAS float* wscr = (LAS float*)(lds + AL_WS) + w * 32;
    constexpr int NPASS = (TYPE == 0) ? 2 : 1;
    unsigned nclaim = 0u;
    const float Mb = (TYPE == 0) ? C.Mb0 : (TYPE == 1) ? C.Mb1 : C.Mb2;
    const int kwoff = w * 1024 + lane * 16, vwoff = ((tid & 7) >> 2) * 4096 + (tid >> 3) * 64 + (tid & 3) * 16;
    const int vb0 = ((lane >> 4) & 1) * 32 + (lane & 3) * 8 + (4 * hi + ((lane & 15) >> 2)) * 64;
    f32x16 o[2], o1[2];
    if (TYPE == 2) { for (int i = tid; i < 257; i += 512) relb[i] = C.rel[h * 257 + i] * LOG2E; }
#pragma unroll
    for (int pass = 0; pass < NPASS; ++pass) {
        int qcol, kcol, vcol;
        if (TYPE == 0) { qcol = pass * 256 + 64 * h; kcol = 512 + pass * 256 + 64 * h; vcol = 1024 + 64 * h; }
        else if (TYPE == 1) { qcol = 1280 + 64 * h; kcol = 1664 + 64 * h; vcol = 2048 + 64 * h; }
        else { qcol = 2432 + 64 * h; kcol = 2816 + 64 * h; vcol = 3200 + 64 * h; }
        const bf16_t* Qp = C.Z + (rowb + sq) * ZP + qcol + 8 * hi;
        bf16x8 qr[4];
#pragma unroll
        for (int d0 = 0; d0 < 4; ++d0) qr[d0] = *(const bf16x8*)(Qp + 16 * d0);
        float cinit = -Mb;
        const float* f2p = C.F2 + (size_t)(b * 6 + h) * SEQ;
        if (TYPE == 1) cinit += f2p[sq];
        f32x16 cvec, zvec;
#pragma unroll
        for (int r = 0; r < 16; ++r) { cvec[r] = cinit; zvec[r] = 0.f; }
#pragma unroll
        for (int r = 0; r < 16; ++r) { o[0][r] = 0.f; o[1][r] = 0.f; }
        float lsum = 0.f;
        const bf16_t* kg = C.Z + (rowb + lane) * ZP + kcol + 8 * w;
        const bf16_t* vg = C.Z + (rowb + (tid >> 3)) * ZP + vcol + 8 * (tid & 7);
        u32x4 kreg = *(const u32x4*)(kg + (size_t)t0 * 64 * ZP), vreg = *(const u32x4*)(vg + (size_t)t0 * 64 * ZP);
        u32x4 kreg2 = *(const u32x4*)(kg + (size_t)(t0 + 1) * 64 * ZP), vreg2 = *(const u32x4*)(vg + (size_t)(t0 + 1) * 64 * ZP);
        float freg = 0.f, freg2 = 0.f;
        if (TYPE == 1 && tid < 64) { freg = f2p[t0 * 64 + tid]; freg2 = f2p[(t0 + 1) * 64 + tid]; }
        __syncthreads();
        for (int t = t0; t < t1; ++t) {
            const int bo = (t & 3) * 8192;
            if ((t & 1) == 0) {
                const int bo1 = ((t + 1) & 3) * 8192;
                *(LAS u32x4*)(Kb + bo + kwoff) = kreg; *(LAS u32x4*)(Vb + bo + vwoff) = vreg;
                *(LAS u32x4*)(Kb + bo1 + kwoff) = kreg2; *(LAS u32x4*)(Vb + bo1 + vwoff) = vreg2;
                if (TYPE == 1 && tid < 64) { Fb[(t & 3) * 64 + tid] = freg; Fb[((t + 1) & 3) * 64 + tid] = freg2; }
                if (t + 2 < t1) {
                    kreg = *(const u32x4*)(kg + (size_t)(t + 2) * 64 * ZP); vreg = *(const u32x4*)(vg + (size_t)(t + 2) * 64 * ZP);
                    kreg2 = *(const u32x4*)(kg + (size_t)(t + 3) * 64 * ZP); vreg2 = *(const u32x4*)(vg + (size_t)(t + 3) * 64 * ZP);
                    if (TYPE == 1 && tid < 64) { freg = f2p[(t + 2) * 64 + tid]; freg2 = f2p[(t + 3) * 64 + tid]; }
                }
                if (pass == NPASS - 1 && t + 2 >= t1 && tid == 0) nclaim = atomicAdd(counter, 1u);
                __syncthreads();
            }
            const bool active = (TYPE == 2) ? (t >= cq - 8 && t <= cq) : (TYPE == 0) ? (t <= cq && (float)(256 * qb + 32 * w - 64 * t - 63) < dmax) : (t <= cq && t >= tfirst);
            if (active) {
                f32x16 p0, p1;
                const LAS unsigned char* kp = Kb + bo + hi * 1024 + r32 * 16;
#pragma unroll
                for (int d0 = 0; d0 < 4; ++d0) {
                    const bf16x8 a0 = *(const LAS bf16x8*)(kp + d0 * 2048), a1 = *(const LAS bf16x8*)(kp + d0 * 2048 + 512);
                    if (d0 == 0) { p0 = MFMA32(a0, qr[0], (TYPE == 1 ? cvec : zvec)); p1 = MFMA32(a1, qr[0], (TYPE == 1 ? cvec : zvec)); }
                    else { p0 = MFMA32(a0, qr[d0], p0); p1 = MFMA32(a1, qr[d0], p1); }
                }
                const int xi = sq - 64 * t - 4 * hi;
                if (TYPE == 0) {
                    const float xf = (float)xi;
#pragma unroll
                    for (int r = 0; r < 16; ++r) { const float c = (float)((r & 3) + 8 * (r >> 2));
                        p0[r] = fast_exp2(p0[r] - sl2 * fabsf(xf - c)); p1[r] = fast_exp2(p1[r] - sl2 * fabsf(xf - (c + 32.f))); }
                } else if (TYPE == 1) {
                    const LAS float* fp = Fb + (t & 3) * 64 + 4 * hi;
#pragma unroll
                    for (int g = 0; g < 4; ++g) { const f32x4 fa = *(const LAS f32x4*)(fp + 8 * g), fb2 = *(const LAS f32x4*)(fp + 32 + 8 * g);
#pragma unroll
                        for (int i = 0; i < 4; i += 2) {
                            const f32x2_t d0_ = (f32x2_t){p0[4 * g + i], p0[4 * g + i + 1]} - (f32x2_t){fa[i], fa[i + 1]}, d1_ = (f32x2_t){p1[4 * g + i], p1[4 * g + i + 1]} - (f32x2_t){fb2[i], fb2[i + 1]};
                            p0[4 * g + i] = fast_exp2(d0_[0]); p0[4 * g + i + 1] = fast_exp2(d0_[1]); p1[4 * g + i] = fast_exp2(d1_[0]); p1[4 * g + i + 1] = fast_exp2(d1_[1]); } }
                    if (t == cq) { const int qrel = 32 * (w & 1) + r32;
#pragma unroll
                        for (int r = 0; r < 16; ++r) { const int kv = crow(r, hi); if (kv > qrel) p0[r] = 0.f; if (kv + 32 > qrel) p1[r] = 0.f; } }
                } else {
                    if (cq - t >= 3) { const float bc = relb[256];
#pragma unroll
                        for (int r = 0; r < 16; ++r) { p0[r] = fast_exp2(p0[r] + bc); p1[r] = fast_exp2(p1[r] + bc); }
                    } else {
#pragma unroll
                        for (int r = 0; r < 16; ++r) { const int c = (r & 3) + 8 * (r >> 2);
                            int i0 = xi - c; i0 = i0 < -128 ? -128 : (i0 > 128 ? 128 : i0); int i1 = xi - c - 32; i1 = i1 < -128 ? -128 : (i1 > 128 ? 128 : i1);
                            p0[r] = fast_exp2(p0[r] + relb[i0 + 128]); p1[r] = fast_exp2(p1[r] + relb[i1 + 128]); }
                    }
                }
                f32x2_t a2 = {0.f, 0.f};
#pragma unroll
                for (int r = 0; r < 16; r += 2) { a2 += (f32x2_t){p0[r], p0[r + 1]}; a2 += (f32x2_t){p1[r], p1[r + 1]}; }
                lsum += a2[0] + a2[1];
                bf16x8 pa[4];
#pragma unroll
                for (int s = 0; s < 2; ++s) {
                    u32x4 a, c2;
                    a.x = pk2(p0[8 * s + 0], p0[8 * s + 1]); a.y = pk2(p0[8 * s + 2], p0[8 * s + 3]); a.z = pk2(p0[8 * s + 4], p0[8 * s + 5]); a.w = pk2(p0[8 * s + 6], p0[8 * s + 7]);
                    c2.x = pk2(p1[8 * s + 0], p1[8 * s + 1]); c2.y = pk2(p1[8 * s + 2], p1[8 * s + 3]); c2.z = pk2(p1[8 * s + 4], p1[8 * s + 5]); c2.w = pk2(p1[8 * s + 6], p1[8 * s + 7]);
                    pa[s] = __builtin_bit_cast(bf16x8, a); pa[2 + s] = __builtin_bit_cast(bf16x8, c2);
                }
                const LAS unsigned char* vp = Vb + bo + vb0;
#pragma unroll
                for (int dh = 0; dh < 2; ++dh)
#pragma unroll
                    for (int ks = 0; ks < 4; ++ks) {
                        const s16x4 lo = vtr(vp + dh * 4096 + ks * 1024), hh = vtr(vp + dh * 4096 + ks * 1024 + 512);
                        const bf16x8 vf = {lo[0], lo[1], lo[2], lo[3], hh[0], hh[1], hh[2], hh[3]};
                        o[dh] = MFMA32(pa[ks], vf, o[dh]);
                    }
            }
        }
        const float ltot = xor32_sum(lsum);
        if (hi == 0) wscr[r32] = 1.0f / ltot;
#pragma unroll
        for (int g = 0; g < 4; ++g) { const f32x4 iv = *(const LAS f32x4*)(wscr + 8 * g + 4 * hi);
#pragma unroll
            for (int i = 0; i < 4; ++i) { o[0][4 * g + i] *= iv[i]; o[1][4 * g + i] *= iv[i]; } }
        if (TYPE == 0) {
            if (pass == 0) { o1[0] = o[0]; o1[1] = o[1]; }
            else {
#pragma unroll
                for (int r = 0; r < 16; ++r) { o[0][r] = o1[0][r] - C.lam * o[0][r]; o[1][r] = o1[1][r] - C.lam * o[1][r]; }
            }
        }
    }
    int ocol;
    if (TYPE == 0) {
        ocol = 64 * h;
        const float g0 = C.subln[r32], g1 = C.subln[32 + r32];
#pragma unroll
        for (int r = 0; r < 16; ++r) {
            float ss = o[0][r] * o[0][r] + o[1][r] * o[1][r];
            ss = xor16_sum(row16_sum(ss));
            const float rs = C.oml * fast_rsq(ss * (1.0f / 64.0f) + EPS);
            o[0][r] *= rs * g0; o[1][r] *= rs * g1;
        }
    } else if (TYPE == 1) ocol = 256 + 64 * h; else ocol = 640 + 64 * h;
    bf16_t* Op = C.O + (rowb + 256 * qb + 32 * w) * DM + ocol + r32;
#pragma unroll
    for (int r = 0; r < 16; ++r) {
        const size_t ro = (size_t)crow(r, hi) * DM;
        Op[ro] = (bf16_t)(pk2(o[0][r], 0.f) & 0xffffu); Op[ro + 32] = (bf16_t)(pk2(o[1][r], 0.f) & 0xffffu);
    }
    if (tid == 0) ((LAS unsigned*)(lds + AL_U))[0] = nclaim;
}

constexpr int ATT_UNITS = 2048;
__device__ __forceinline__ void attn_phase(const AttnCtx& C, unsigned* counter, LAS unsigned char* lds, int tid) {
    LAS unsigned* ub = (LAS unsigned*)(lds + AL_U);
    __syncthreads();
    if (tid == 0) ub[0] = atomicAdd(counter, 1u);
    for (;;) {
        __syncthreads();
        const int u = (int)ub[0];
        if (u >= ATT_UNITS) break;
        int ty, ub_, uh, uq;
        if (u < 256) { ty = 0; ub_ = (u & 31) >> 2; uh = u & 3; uq = 15 - (u >> 5); }
        else if (u < 1280) { const int v = u - 256, q = 7 - (v >> 7), wv = v & 127;
            if (wv < 32) { ty = 0; ub_ = wv >> 2; uh = wv & 3; uq = q; }
            else if (wv < 80) { ty = 1; ub_ = (wv - 32) / 6; uh = (wv - 32) % 6; uq = 2 * q + 1; }
            else { ty = 1; ub_ = (wv - 80) / 6; uh = (wv - 80) % 6; uq = 2 * q; } }
        else { const int v = u - 1280; ty = 2; ub_ = (v % 48) / 6; uh = (v % 48) % 6; uq = 15 - v / 48; }
        if (ty == 0) attn_unit<0>(C, ub_, uh, uq, lds, tid, counter);
        else if (ty == 1) attn_unit<1>(C, ub_, uh, uq, lds, tid, counter);
        else attn_unit<2>(C, ub_, uh, uq, lds, tid, counter);
    }
}
struct Args { const float* in[18]; float* out; unsigned char* ws; };
constexpr int LDS_TOTAL = 149760, LDS_XCH = 131072, LDS_PRM = LDS_XCH + 8256, LDS_RSD = LDS_PRM + 8192;
#ifdef PROBE_SYNC2
#define GSYNC() do { xcd_barrier(xbar, K_TID == 0); xcd_barrier(xbar, K_TID == 0); } while (0)
#else
#define GSYNC() xcd_barrier(xbar, K_TID == 0)
#endif
__device__ __forceinline__ int lane_fresh() { unsigned m = ~0u; asm volatile("" : "+s"(m)); int t = (int)__builtin_amdgcn_mbcnt_hi(m, __builtin_amdgcn_mbcnt_lo(m, 0u)); asm volatile("" : "+v"(t)); return t; }
typedef const __attribute__((address_space(4))) Args* kargs_t;
__device__ __forceinline__ kargs_t kargs() { kargs_t p = (kargs_t)__builtin_amdgcn_kernarg_segment_ptr(); asm volatile("" : "+s"(p)); return p; }
#define AIN(i) (kargs()->in[i])
#define AOUT (kargs()->out)
#define AWS (kargs()->ws)
#define P_HN ((bf16_t*)(AWS + WS_HN))
#define P_Zb ((bf16_t*)(AWS + WS_Z))
#define P_LOGF ((float*)(AWS + WS_LOGF))
#define P_F2 ((float*)(AWS + WS_F2))
#define P_EDGE ((float*)(AWS + WS_EDGE))
#define P_PB ((bf16_t*)(AWS + WS_PB))
#define P_HB ((bf16_t*)(AWS + WS_HB))
#define P_RSQ ((u64_t*)(AWS + WS_RSQ))

__global__ void __launch_bounds__(512, 2) fwd_megakernel(Args a) {
    __shared__ __attribute__((aligned(16))) unsigned char lds_raw[LDS_TOTAL];
    cg::grid_group grid = cg::this_grid();
    LAS unsigned char* lds = (LAS unsigned char*)lds_raw;
    const int G = gridDim.x, bx = blockIdx.x, NGW = G * 8;
    const int wave_s = __builtin_amdgcn_readfirstlane((int)threadIdx.x >> 6);
#define K_TID ((wave_s << 6) | lane_fresh())
#define K_LANE (lane_fresh())
#define K_WAVE (wave_s)
#define K_GW (bx * 8 + K_WAVE)
    volatile LAS unsigned* xst = (volatile LAS unsigned*)(lds + LDS_XCH + 8192);
    if (K_TID < 4) xst[K_TID] = 0u;
    __syncthreads();
    XcdBarrier xbar = xcd_barrier_post((unsigned*)(AWS + WS_CTL), xst);
#ifdef PROBE_P0X2
    for (int rep_ = 0; rep_ < 2; ++rep_)
#endif
    {
        LAS float* scr = (LAS float*)(lds + K_WAVE * 8448);
        constexpr int I_IN = 16 * 112, I_OUT = 16 * 32, I_UP = 16 * 176, I_DN = 44 * 32, I_GT = 16 * 32, I_PJ = 4 * 32, I_L = I_IN + I_OUT + I_UP + I_DN + I_GT + I_PJ;
        for (int it = K_GW; it < 2 * I_L; it += NGW) {
            const int l = it / I_L; int r = it % I_L;
            if (r < I_IN) { transpose_item<1>(AIN(3) + (size_t)l * DM * INC, DM, INC, ZP, (bf16_t*)(AWS + WS_WIN + l * SZ_WIN), scr, r, K_LANE); continue; } r -= I_IN;
            if (r < I_OUT) { transpose_item<0>(AIN(9) + (size_t)l * DM * DM, DM, DM, DM, (bf16_t*)(AWS + WS_WOUT + l * SZ_WOUT), scr, r, K_LANE); continue; } r -= I_OUT;
            if (r < I_UP) { transpose_item<2>(AIN(11) + (size_t)l * DM * UPN, DM, UPN, UPN, (bf16_t*)(AWS + WS_WUP + l * SZ_WUP), scr, r, K_LANE, AIN(10) + l * DM); continue; } r -= I_UP;
            if (r < I_DN) { transpose_item<0>(AIN(14) + (size_t)l * DFF * DM, DFF, DM, DM, (bf16_t*)(AWS + WS_WDN + l * SZ_WDN), scr, r, K_LANE); continue; } r -= I_DN;
            if (r < I_GT) { transpose_item<0>(AIN(16) + (size_t)l * DM * DM, DM, DM, DM, (bf16_t*)(AWS + WS_WGT + l * SZ_WGT), scr, r, K_LANE, AIN(15) + l * DM); continue; } r -= I_GT;
            transpose_item<0>(AIN(17) + (size_t)l * PLED * DM, PLED, DM, DM, (bf16_t*)(AWS + WS_WPJ + l * SZ_WPJ), scr, r, K_LANE);
        }
        { unsigned* rq = (unsigned*)P_RSQ; for (int i = bx * 512 + K_TID; i < 8 * T; i += G * 512) rq[i] = 0u; }
        const size_t n8 = (size_t)2 * T * PLED / 8; const float* pp_ = AIN(1); bf16_t* pb_ = P_PB;
        for (size_t i = (size_t)bx * 512 + K_TID; i < n8; i += (size_t)G * 512) {
            const f32x4 v0 = *(const f32x4*)(pp_ + 8 * i), v1 = *(const f32x4*)(pp_ + 8 * i + 4);
            u32x4 w; w.x = pk2(v0[0], v0[1]); w.y = pk2(v0[2], v0[3]); w.z = pk2(v1[0], v1[1]); w.w = pk2(v1[2], v1[3]);
            *(u32x4*)(pb_ + 8 * i) = w;
        }
    }

    auto layer = [&](const int l) __attribute__((always_inline)) {

        {
#ifndef SKIP_NORMFG
            int lane_l = K_LANE, gw_l = K_GW; asm volatile("" : "+v"(lane_l), "+s"(gw_l));
#ifdef PROBE_P0X2
            for (int rep_ = 0; rep_ < 2; ++rep_)
#endif
            if (l == 0) norm_phase<true, false>(AIN(0), AIN(2) + l * DM, P_HN, AIN(3) + (size_t)l * DM * INC, AIN(7) + l * 6, P_LOGF, gw_l, NGW, lane_l);
            else norm_phase<true, true>((const float*)P_HB, AIN(2) + l * DM, P_HN, AIN(3) + (size_t)l * DM * INC, AIN(7) + l * 6, P_LOGF, gw_l, NGW, lane_l);
#endif
            if (l == 0 && gridDim.x > 1000000u) grid.sync();
            GSYNC();
        }
        {
#ifndef SKIP_SCAN
            if (bx < 48) { int tid_l = K_TID, bh_l = bx; asm volatile("" : "+v"(tid_l), "+s"(bh_l)); scan_unit(P_LOGF, P_F2, bh_l, (LAS double*)lds, tid_l); }
#endif
#ifndef SKIP_QKV
            pg8::Gemm g{P_HN, (const bf16_t*)(AWS + WS_WIN + l * SZ_WIN), T, ZP, DM}; pg8::StaticOrder S; S.init(T, ZP, G, bx);
            pg8::EpiQKV E{P_Zb, AIN(4) + l * 6 * 64};
#ifdef PROBE_PLAINQKV
            { pg8::EpiPlain EP{P_Zb}; pg8::gemm_phase<pg8::EpiPlain, pg8::StaticOrder, true, true>(lds, g, S, EP, K_TID); }
#endif
            pg8::gemm_phase<pg8::EpiQKV, pg8::StaticOrder, true, true>(lds, g, S, E, K_TID);
#ifdef PROBE_QKV2
            pg8::gemm_phase<pg8::EpiQKV, pg8::StaticOrder, true, true>(lds, g, S, E, K_TID);
#endif
#endif
        }
        GSYNC();
        {
            int lane_l = K_LANE, tid_l = K_TID; asm volatile("" : "+v"(lane_l), "+v"(tid_l));
            const float* gq = AIN(4) + l * 6 * 64;
            float mg[6];
#pragma unroll
            for (int j = 0; j < 6; ++j) mg[j] = wave_max(fabsf(gq[j * 64 + lane_l]));
            const float* rel = AIN(8) + l * 6 * 257;
            float mr = 0.f;
            for (int i = lane_l; i < 6 * 257; i += 64) mr = fmaxf(mr, fabsf(rel[i]));
            mr = wave_max(mr);
            const float* lp = AIN(5) + l * 4 * 64;
            const float s01 = wave_sum(lp[lane_l] * lp[64 + lane_l]), s23 = wave_sum(lp[128 + lane_l] * lp[192 + lane_l]);
            const float lam_init = (l == 0) ? 0.2f : (0.8f - 0.6f * 0.7408182206817179f);
            AttnCtx C;
            C.Z = P_Zb; C.O = P_HN; C.F2 = P_F2; C.rel = rel; C.subln = AIN(6) + l * 64;
            C.lam = expf(s01) - expf(s23) + lam_init; C.oml = 1.0f - lam_init;
            C.Mb0 = 8.0f * mg[0] * mg[1] * LOG2E * 1.02f + 1.0f; C.Mb1 = 8.0f * mg[2] * mg[3] * LOG2E * 1.02f + 1.0f; C.Mb2 = 8.0f * mg[4] * mg[5] * LOG2E * 1.02f + 1.0f + mr * LOG2E;
#ifndef SKIP_ATTN
            #define RFL(x) __uint_as_float(__builtin_amdgcn_readfirstlane(__float_as_uint(x)))
            C.lam = RFL(C.lam); C.oml = RFL(C.oml); C.Mb0 = RFL(C.Mb0); C.Mb1 = RFL(C.Mb1); C.Mb2 = RFL(C.Mb2);
            attn_phase(C, (unsigned*)(AWS + WS_CTL) + CTL_Q + 16 * (1 + l), lds, tid_l);
#ifdef PROBE_ATTN2
            attn_phase(C, (unsigned*)(AWS + WS_CTL) + CTL_Q + 16 * (1 + l) + 8, lds, tid_l);
#endif
#endif
        }
        GSYNC();
        {
            pg8::Gemm g{P_HN, (const bf16_t*)(AWS + WS_WOUT + l * SZ_WOUT), T, DM, DM}; pg8::StaticOrder S; S.init(T, DM, G, bx);
            pg8::EpiResid E{(l == 0) ? AIN(0) : (const float*)nullptr, P_HB, P_RSQ + (size_t)(2 * l) * T};
            pg8::gemm_phase<pg8::EpiResid, pg8::StaticOrder, true, true>(lds, g, S, E, K_TID);
        }
        GSYNC();
        {
            pg8::Gemm g{P_HB, (const bf16_t*)(AWS + WS_WUP + l * SZ_WUP), T, UPN, DM}; pg8::StaticOrder S; S.init(T, UPN, G, bx);
            pg8::EpiUp E{P_Zb, AIN(12) + (size_t)l * 3 * UPN, AIN(13) + l * UPN, P_EDGE, (LAS float*)(lds + LDS_XCH), P_RSQ + (size_t)(2 * l) * T, (LAS float*)(lds + LDS_PRM), (LAS float*)(lds + LDS_RSD)};
#ifndef SKIP_UP
            pg8::gemm_phase<pg8::EpiUp, pg8::StaticOrder, true, true>(lds, g, S, E, K_TID);
#ifdef PROBE_UP2
            pg8::gemm_phase<pg8::EpiUp, pg8::StaticOrder, true, true>(lds, g, S, E, K_TID);
#endif
#endif
        }
        GSYNC();
        {
            pg8::Gemm g{P_Zb, (const bf16_t*)(AWS + WS_WDN + l * SZ_WDN), T, DM, DFF}; pg8::StaticOrder S; S.init(T, DM, G, bx);
            pg8::Unit u;
            int tid_l = K_TID; asm volatile("" : "+v"(tid_l));
            for (int i = 0; S.next(i, u); ++i) fix_rows(P_Zb, P_EDGE, AIN(12) + (size_t)l * 3 * UPN, AIN(13) + l * UPN, u.pm, tid_l);
            __threadfence();
            __syncthreads();
            pg8::EpiResid E{nullptr, P_HB, P_RSQ + (size_t)(2 * l + 1) * T};
            pg8::gemm_phase<pg8::EpiResid, pg8::StaticOrder, true, true>(lds, g, S, E, K_TID);
        }
        GSYNC();
        {
            bf16_t* SG = P_Zb;
            pg8::StaticOrder S; S.init(T, DM, G, bx);
            { pg8::Gemm g{P_HB, (const bf16_t*)(AWS + WS_WGT + l * SZ_WGT), T, DM, DM}; pg8::EpiSig E{SG, P_RSQ + (size_t)(2 * l + 1) * T};
              pg8::gemm_phase<pg8::EpiSig, pg8::StaticOrder, true, true>(lds, g, S, E, K_TID);
#ifdef PROBE_SIG2
              pg8::gemm_phase<pg8::EpiSig, pg8::StaticOrder, true, true>(lds, g, S, E, K_TID);
#endif
            }
            GSYNC();
            { int kple = PLED; asm volatile("" : "+s"(kple));
              pg8::Gemm g{P_PB + (size_t)l * T * PLED, (const bf16_t*)(AWS + WS_WPJ + l * SZ_WPJ), T, DM, kple}; pg8::EpiMulAdd E{SG, P_HB, (l == 1) ? AOUT : (float*)nullptr};
              pg8::gemm_phase<pg8::EpiMulAdd, pg8::StaticOrder, true, true>(lds, g, S, E, K_TID); }
        }
        if (l == 0) GSYNC();
    };
    layer(0);
    layer(1);
}

extern "C" void kernel_launch(void* const* d_in, const int* in_sizes, int n_in, void* d_out, int out_size, void* d_ws, size_t ws_size, hipStream_t stream) {
    static int grid_blocks = 0;
    if (!grid_blocks) {
        int dev = 0, cus = 0, per_cu = 0;
        hipGetDevice(&dev);
        hipDeviceGetAttribute(&cus, hipDeviceAttributeMultiprocessorCount, dev);
        hipOccupancyMaxActiveBlocksPerMultiprocessor(&per_cu, fwd_megakernel, 512, 0);
        if (per_cu < 1) per_cu = 1;
        if (cus < 1) cus = 256;
        grid_blocks = cus * 1;
        if (n_in != 18 || ws_size < WS_END) fprintf(stderr, "kernel_launch: unexpected n_in %d or ws_size %zu (< %zu)\n", n_in, ws_size, (size_t)WS_END);
    }
    hipMemsetAsync(d_ws, 0, 16384, stream);
    Args a{};
    for (int i = 0; i < 18; ++i) a.in[i] = (const float*)d_in[i];
    a.out = (float*)d_out; a.ws = (unsigned char*)d_ws;
    void* args[] = {&a};
    hipError_t e = hipLaunchCooperativeKernel((void*)fwd_megakernel, dim3(grid_blocks), dim3(512), args, 0, stream);
    if (e != hipSuccess) fprintf(stderr, "cooperative launch failed: %s (grid %d)\n", hipGetErrorString(e), grid_blocks);
}
```

```cpp
#include <hip/hip_runtime.h>
#include <hip/hip_cooperative_groups.h>
#include <cstdio>
#include <cstdint>
namespace cg = cooperative_groups;

#define LAS __attribute__((address_space(3)))
typedef unsigned short bf16_t;
typedef short bf16x8 __attribute__((ext_vector_type(8)));
typedef short s16x4 __attribute__((ext_vector_type(4)));
typedef float f32x4 __attribute__((ext_vector_type(4)));
typedef float f32x16 __attribute__((ext_vector_type(16)));
typedef unsigned u32x4 __attribute__((ext_vector_type(4)));
typedef unsigned u32x2 __attribute__((ext_vector_type(2)));
typedef float f32x2_t __attribute__((ext_vector_type(2)));
typedef __bf16 bf16x2_t __attribute__((ext_vector_type(2)));

constexpr int NB = 8, SEQ = 4096, T = NB * SEQ, DM = 1024, ZP = 3584, DFF = 2816, UPN = 5632, PLED = 256, INC = 3590;
constexpr float EPS = 1e-6f, LOG2E = 1.4426950408889634f, C2 = 0.125f * 1.4426950408889634f;

constexpr size_t WS_CTL = 0;
constexpr size_t SZ_WIN = (size_t)ZP * DM * 2, SZ_WOUT = (size_t)DM * DM * 2, SZ_WUP = (size_t)UPN * DM * 2, SZ_WDN = (size_t)DM * DFF * 2, SZ_WGT = (size_t)DM * DM * 2, SZ_WPJ = (size_t)DM * PLED * 2;
constexpr size_t SZ_PB = (size_t)T * PLED * 2, SZ_HN = (size_t)T * DM * 2, SZ_Z = (size_t)T * ZP * 2, SZ_LOGF = (size_t)T * 6 * 4, SZ_EDGE = (size_t)128 * 22 * 1024 * 4;
constexpr size_t WS_WIN = 16384;
constexpr int CTL_Q = 3584;
constexpr size_t WS_WOUT = WS_WIN + 2 * SZ_WIN;
constexpr size_t WS_WUP = WS_WOUT + 2 * SZ_WOUT;
constexpr size_t WS_WDN = WS_WUP + 2 * SZ_WUP;
constexpr size_t WS_WGT = WS_WDN + 2 * SZ_WDN;
constexpr size_t WS_WPJ = WS_WGT + 2 * SZ_WGT;
constexpr size_t WS_PB = WS_WPJ + 2 * SZ_WPJ;
constexpr size_t WS_HN = WS_PB + 2 * SZ_PB;
constexpr size_t WS_Z = WS_HN + SZ_HN;
constexpr size_t WS_LOGF = WS_Z + SZ_Z;
constexpr size_t WS_F2 = WS_LOGF + SZ_LOGF;
constexpr size_t WS_EDGE = WS_F2 + SZ_LOGF;
constexpr size_t WS_HB = WS_EDGE + SZ_EDGE;
constexpr size_t WS_RSQ = WS_HB + SZ_HN;
constexpr size_t SZ_RSQ = (size_t)4 * T * 8;
constexpr size_t WS_END = WS_RSQ + SZ_RSQ;

__device__ __forceinline__ unsigned pk2(float lo, float hi) { f32x2_t v = {lo, hi}; bf16x2_t b = __builtin_convertvector(v, bf16x2_t); return __builtin_bit_cast(unsigned, b); }
#define DPPF(v, ctrl) __builtin_bit_cast(float, __builtin_amdgcn_update_dpp(0, __builtin_bit_cast(int, (v)), (ctrl), 0xf, 0xf, false))
__device__ __forceinline__ float xor16_sum(float v) { const auto r = __builtin_amdgcn_permlane16_swap(__float_as_uint(v), __float_as_uint(v), false, false); return __uint_as_float(r[0]) + __uint_as_float(r[1]); }
__device__ __forceinline__ float xor32_sum(float v) { const auto r = __builtin_amdgcn_permlane32_swap(__float_as_uint(v), __float_as_uint(v), false, false); return __uint_as_float(r[0]) + __uint_as_float(r[1]); }
__device__ __forceinline__ float xor16_max(float v) { const auto r = __builtin_amdgcn_permlane16_swap(__float_as_uint(v), __float_as_uint(v), false, false); return fmaxf(__uint_as_float(r[0]), __uint_as_float(r[1])); }
__device__ __forceinline__ float xor32_max(float v) { const auto r = __builtin_amdgcn_permlane32_swap(__float_as_uint(v), __float_as_uint(v), false, false); return fmaxf(__uint_as_float(r[0]), __uint_as_float(r[1])); }
__device__ __forceinline__ float row16_sum(float v) { v += DPPF(v, 0xB1); v += DPPF(v, 0x4E); v += DPPF(v, 0x141); v += DPPF(v, 0x140); return v; }
__device__ __forceinline__ float wave_sum(float v) { return xor32_sum(xor16_sum(row16_sum(v))); }
__device__ __forceinline__ float wave_max(float v) {
    v = fmaxf(v, DPPF(v, 0xB1)); v = fmaxf(v, DPPF(v, 0x4E)); v = fmaxf(v, DPPF(v, 0x141)); v = fmaxf(v, DPPF(v, 0x140));
    return xor32_max(xor16_max(v));
}
__device__ __forceinline__ float fast_exp2(float x) { return __builtin_amdgcn_exp2f(x); }
__device__ __forceinline__ float fast_rcp(float x) { return __builtin_amdgcn_rcpf(x); }
__device__ __forceinline__ float fast_rsq(float x) { return __builtin_amdgcn_rsqf(x); }
typedef unsigned long long u64_t;
__device__ __forceinline__ float rsq_sum(const u64_t* rsq, int row) { return (float)rsq[row] * (1.0f / 16777216.0f); }
__device__ __forceinline__ float row_rstd(const u64_t* rsq, int row) { return fast_rsq(rsq_sum(rsq, row) * (1.0f / DM) + EPS); }
__device__ __forceinline__ float sigmoidf_(float v) { return fast_rcp(1.0f + fast_exp2(-v * LOG2E)); }
#define XB_TMO      128
#define XB_XCNT(j)  (256  + 64 * (j))
#define XB_XSUB(j)  (1280 + 64 * (j))
#define XB_XGEN(j)  (2304 + 64 * (j))
#define XB_TOP      3328
#define XB_TOPGEN   3392
#define XCD_BAR_WORDS 3456
#define XB_SPIN_CAP (1u << 18)
__device__ __forceinline__ unsigned xb_ld(unsigned* p)              { return __hip_atomic_load(p, __ATOMIC_RELAXED, __HIP_MEMORY_SCOPE_AGENT); }
__device__ __forceinline__ unsigned xb_add(unsigned* p, unsigned v) { return __hip_atomic_fetch_add(p, v, __ATOMIC_RELAXED, __HIP_MEMORY_SCOPE_AGENT); }
__device__ __forceinline__ unsigned xb_xcc_id() { return (unsigned)__builtin_amdgcn_s_getreg((3 << 11) | 20) & 0xFu; }
#define XB_SPIN(cond, bar) do { unsigned _sp = 0; while (cond) { __builtin_amdgcn_s_sleep(1); \
    if ((++_sp & 255u) == 0u) { if (xb_ld(&(bar)[XB_TMO])) break; if (_sp > XB_SPIN_CAP) { atomicAdd(&(bar)[XB_TMO], 1u); break; } } } } while (0)

struct XcdBarrier {
    unsigned* bar; unsigned x;
    volatile LAS unsigned* st;
};

__device__ __forceinline__ XcdBarrier xcd_barrier_post(unsigned* bar, volatile LAS unsigned* st) {
    XcdBarrier b; b.bar = bar; b.x = xb_xcc_id(); b.st = st;
    if (threadIdx.x == 0) (void)xb_add(&bar[XB_XCNT(b.x)], 1u);
    return b;
}
__device__ __forceinline__ void xcd_barrier_complete(unsigned* bar, unsigned x, unsigned& nloc, unsigned& nx) {
    const unsigned G = gridDim.x * gridDim.y * gridDim.z;
    unsigned sum, cnt, mine, sp = 0u;
    for (;;) {
        sum = 0u; cnt = 0u; mine = 0u;
#pragma unroll
        for (unsigned j = 0; j < 16; ++j) { const unsigned c = xb_ld(&bar[XB_XCNT(j)]); sum += c; cnt += (c > 0u) ? 1u : 0u; mine = (j == x) ? c : mine; }
        if (sum == G) break;
        __builtin_amdgcn_s_sleep(1);
        if ((++sp & 255u) == 0u) { if (xb_ld(&bar[XB_TMO])) break; if (sp > XB_SPIN_CAP) { atomicAdd(&bar[XB_TMO], 1u); break; } }
    }
    nloc = mine > 0u ? mine : 1u; nx = cnt > 0u ? cnt : 1u;
}

__device__ __forceinline__ void xcd_barrier(const XcdBarrier& b, const bool xb_is_leader) {
    asm volatile("s_waitcnt vmcnt(0)" ::: "memory");
    __syncthreads();
    if (xb_is_leader) {
        unsigned* bar = b.bar;
        __builtin_amdgcn_s_waitcnt(0);
        unsigned nloc = b.st[0], nx = b.st[1];
        if (nloc == 0u) { xcd_barrier_complete(bar, b.x, nloc, nx); b.st[0] = nloc; b.st[1] = nx; }
        const unsigned old = xb_add(&bar[XB_XSUB(b.x)], 1u);
        const unsigned gen = old / nloc;
        if (old + 1u == (gen + 1u) * nloc) {
            __builtin_amdgcn_fence(__ATOMIC_RELEASE, "agent");
            asm volatile("s_waitcnt vmcnt(0)" ::: "memory");
            const unsigned og = xb_add(&bar[XB_TOP], 1u);
            const unsigned tg = og / nx;
            if (og + 1u == (tg + 1u) * nx) xb_add(&bar[XB_TOPGEN], 1u);
            else XB_SPIN(xb_ld(&bar[XB_TOPGEN]) == tg, bar);
            __builtin_amdgcn_fence(__ATOMIC_ACQUIRE, "agent");
            xb_add(&bar[XB_XGEN(b.x)], 1u);
            asm volatile("s_waitcnt vmcnt(0)" ::: "memory");
        } else {
            XB_SPIN(xb_ld(&bar[XB_XGEN(b.x)]) == gen, bar);
            __builtin_amdgcn_fence(__ATOMIC_ACQUIRE, "agent");
            asm volatile("s_waitcnt vmcnt(0)" ::: "memory");
        }
    }
    __syncthreads();
}
namespace pg8 {
#define PG8_LAS __attribute__((address_space(3)))
typedef unsigned short bf16_t;
typedef short bf16x8 __attribute__((ext_vector_type(8)));
typedef float f32x4 __attribute__((ext_vector_type(4)));
typedef unsigned u32x4 __attribute__((ext_vector_type(4)));
constexpr int BM = 256, BK = 64, HALF = 128, HTB = HALF * BK * 2  , STAGE_BYTES = 8 * HTB, NXCD = 8, WGM = 8;

__host__ __device__ __forceinline__ int lds_byte(int r, int c) { const int st = (r >> 4) * 2 + (c >> 5), rr = r & 15, cc = c & 31, ob = rr * 64 + cc * 2; return st * 1024 + (ob ^ (((ob >> 9) & 1) << 5)); }
__host__ __device__ __forceinline__ void stage_rc(int b, int& R, int& C) { const int st = b / 1024, sb = b % 1024, swz = sb ^ (((sb >> 9) & 1) << 5); R = (st >> 1) * 16 + swz / 64; C = (st & 1) * 32 + (swz % 64) / 2; }
__host__ __device__ __forceinline__ int perm32(int rho) { const int n = rho >> 4, i = rho & 15; return 8 * (i >> 2) + 4 * n + (i & 3); }

struct Unit { int pm, pn; };
struct Gemm { const bf16_t* A; const bf16_t* Bt; int M, N, K; };

struct StaticOrder {
    int nM, nN, nwg, G, c;
    __host__ __device__ void init(int M, int N, int G_, int c_) { nM = M / BM; nN = N / BM; nwg = nM * nN; G = G_; c = c_; }
    __host__ __device__ bool next(int i, Unit& u) const {
        const long L = (long)i * G + c; if (L >= nwg) return false;
        int wgid = (int)L; { const int q = nwg / NXCD, r = nwg % NXCD, xcd = wgid % NXCD, off = wgid / NXCD; wgid = (xcd < r ? xcd * (q + 1) : r * (q + 1) + (xcd - r) * q) + off; }
        const int nig = WGM * nN, gid = wgid / nig, fm = gid * WGM, gsz = (nM - fm) < WGM ? (nM - fm) : WGM;
        u.pm = fm + ((wgid % nig) % gsz); u.pn = (wgid % nig) / gsz; return true;
    }
    __device__ __forceinline__ void a_ready(const Unit&) const {}
    __device__ __forceinline__ void done(const Unit&) const {}
};

#define BPERM(v, srclane) __builtin_bit_cast(float, __builtin_amdgcn_ds_bpermute((srclane) << 2, __builtin_bit_cast(int, (float)(v))))
#define PG8_EPI_BAR() do { asm volatile("s_waitcnt lgkmcnt(0)" ::: "memory"); __builtin_amdgcn_s_barrier(); asm volatile("" ::: "memory"); } while (0)

struct EpiQKV {
    static constexpr bool PERM = true, AFTER_DRAIN = false, WANTS_NEXT = false, PERMA = false;
    bf16_t* Z; const float* gain;
    __device__ __forceinline__ void operator()(const f32x4 (&acc)[2][2][4][2], const Unit& u, int wr, int wc, int fr_in, int fq_in) const {
        int fr = fr_in, fq = fq_in; asm volatile("" : "+v"(fr), "+v"(fq));
        const int G = 4 * u.pn + wc;
        int gi; float sc = 1.f;
        if (G < 8) { gi = 0; sc = C2; } else if (G < 16) gi = 1; else if (G < 20) gi = -1; else if (G < 26) { gi = 2; sc = C2; } else if (G < 32) gi = 3;
        else if (G < 38) gi = -1; else if (G < 44) { gi = 4; sc = C2; } else if (G < 50) gi = 5; else gi = -1;
        f32x4 g[2][2];
#pragma unroll
        for (int bj = 0; bj < 2; ++bj) { g[bj][0] = (f32x4){1.f, 1.f, 1.f, 1.f}; g[bj][1] = g[bj][0]; }
        if (gi >= 0) {
#pragma unroll
            for (int bj = 0; bj < 2; ++bj) { const float* gp = gain + gi * 64 + 32 * bj + 8 * fq; g[bj][0] = *(const f32x4*)gp * sc; g[bj][1] = *(const f32x4*)(gp + 4) * sc; }
        }
        bf16_t* zb = Z + (size_t)(u.pm * BM + wr * 64 + fr) * ZP + u.pn * BM + wc * 64 + 8 * fq;
#pragma unroll
        for (int ai = 0; ai < 2; ++ai)
#pragma unroll
            for (int m = 0; m < 4; ++m) {
                float rstd = 1.f;
                if (gi >= 0) {
                    float s = 0.f;
#pragma unroll
                    for (int bj = 0; bj < 2; ++bj) { const f32x4 x0 = acc[ai][bj][m][0], x1 = acc[ai][bj][m][1];
                        s += (x0[0] * x0[0] + x0[1] * x0[1]) + (x0[2] * x0[2] + x0[3] * x0[3]) + (x1[0] * x1[0] + x1[1] * x1[1]) + (x1[2] * x1[2] + x1[3] * x1[3]); }
                    s = xor32_sum(xor16_sum(s));
                    rstd = fast_rsq(s * (1.0f / 64.0f) + EPS);
                }
#pragma unroll
                for (int bj = 0; bj < 2; ++bj) {
                    const f32x4 v0 = acc[ai][bj][m][0] * g[bj][0] * rstd, v1 = acc[ai][bj][m][1] * g[bj][1] * rstd;
                    u32x4 w; w.x = pk2(v0[0], v0[1]); w.y = pk2(v0[2], v0[3]); w.z = pk2(v1[0], v1[1]); w.w = pk2(v1[2], v1[3]);
                    *(u32x4*)(zb + (size_t)(ai * 128 + m * 16) * ZP + 32 * bj) = w;
                }
            }
    }
};

struct EpiPlain {
    static constexpr bool PERM = true, AFTER_DRAIN = false, WANTS_NEXT = false, PERMA = false;
    bf16_t* Z;
    __device__ __forceinline__ void operator()(const f32x4 (&acc)[2][2][4][2], const Unit& u, int wr, int wc, int fr_in, int fq_in) const {
        int fr = fr_in, fq = fq_in; asm volatile("" : "+v"(fr), "+v"(fq));
#pragma unroll
        for (int ai = 0; ai < 2; ++ai)
#pragma unroll
            for (int m = 0; m < 4; ++m)
#pragma unroll
                for (int bj = 0; bj < 2; ++bj) {
                    const f32x4 v0 = acc[ai][bj][m][0], v1 = acc[ai][bj][m][1];
                    u32x4 w; w.x = pk2(v0[0], v0[1]); w.y = pk2(v0[2], v0[3]); w.z = pk2(v1[0], v1[1]); w.w = pk2(v1[2], v1[3]);
                    *(u32x4*)(Z + (size_t)(u.pm * BM + ai * 128 + wr * 64 + m * 16 + fr) * ZP + u.pn * BM + bj * HALF + wc * 32 + 8 * fq) = w;
                }
    }
};

#define BF16_LO(w) __uint_as_float((w) << 16)
#define BF16_HI(w) __uint_as_float((w) & 0xffff0000u)
struct EpiResid {
    static constexpr bool PERM = true, AFTER_DRAIN = false, WANTS_NEXT = false, PERMA = false;
    const float* xbase; bf16_t* hb; u64_t* rsq;
    __device__ __forceinline__ void operator()(const f32x4 (&acc)[2][2][4][2], const Unit& u, int wr, int wc, int fr_in, int fq_in) const {
        int fr = fr_in, fq = fq_in; asm volatile("" : "+v"(fr), "+v"(fq));
#pragma unroll
        for (int ai = 0; ai < 2; ++ai)
#pragma unroll
            for (int m = 0; m < 4; ++m) {
                const int row = u.pm * BM + ai * 128 + wr * 64 + m * 16 + fr;
                float s = 0.f;
#pragma unroll
                for (int bj = 0; bj < 2; ++bj) {
                    const size_t off = (size_t)row * DM + u.pn * BM + bj * HALF + wc * 32 + 8 * fq;
                    f32x4 b0, b1;
                    if (xbase) { b0 = *(const f32x4*)(xbase + off); b1 = *(const f32x4*)(xbase + off + 4); }
                    else { const u32x4 q = *(const u32x4*)(hb + off);
                        b0 = (f32x4){BF16_LO(q.x), BF16_HI(q.x), BF16_LO(q.y), BF16_HI(q.y)}; b1 = (f32x4){BF16_LO(q.z), BF16_HI(q.z), BF16_LO(q.w), BF16_HI(q.w)}; }
                    const f32x4 h0 = b0 + acc[ai][bj][m][0], h1 = b1 + acc[ai][bj][m][1];
                    u32x4 w; w.x = pk2(h0[0], h0[1]); w.y = pk2(h0[2], h0[3]); w.z = pk2(h1[0], h1[1]); w.w = pk2(h1[2], h1[3]);
                    *(u32x4*)(hb + off) = w;
                    s += (h0[0] * h0[0] + h0[1] * h0[1]) + (h0[2] * h0[2] + h0[3] * h0[3]) + (h1[0] * h1[0] + h1[1] * h1[1]) + (h1[2] * h1[2] + h1[3] * h1[3]);
                }
                s = xor32_sum(xor16_sum(s));
                if (fq == 0) atomicAdd(rsq + row, (u64_t)(s * 16777216.0f));
                if (m == 3) asm volatile("" ::: "memory");
            }
    }
};

struct EpiSig {
    static constexpr bool PERM = true, AFTER_DRAIN = false, WANTS_NEXT = false, PERMA = false;
    bf16_t* SG; const u64_t* rsq;
    __device__ __forceinline__ void operator()(const f32x4 (&acc)[2][2][4][2], const Unit& u, int wr, int wc, int fr_in, int fq_in) const {
        int fr = fr_in, fq = fq_in; asm volatile("" : "+v"(fr), "+v"(fq));
#pragma unroll
        for (int ai = 0; ai < 2; ++ai)
#pragma unroll
            for (int m = 0; m < 4; ++m) {
                const int row = u.pm * BM + ai * 128 + wr * 64 + m * 16 + fr;
                const float rs = row_rstd(rsq, row);
#pragma unroll
                for (int bj = 0; bj < 2; ++bj) {
                    const size_t off = (size_t)row * DM + u.pn * BM + bj * HALF + wc * 32 + 8 * fq;
                    const f32x4 a = acc[ai][bj][m][0] * rs, b = acc[ai][bj][m][1] * rs;
                    u32x4 w; w.x = pk2(sigmoidf_(a[0]), sigmoidf_(a[1])); w.y = pk2(sigmoidf_(a[2]), sigmoidf_(a[3]));
                    w.z = pk2(sigmoidf_(b[0]), sigmoidf_(b[1])); w.w = pk2(sigmoidf_(b[2]), sigmoidf_(b[3]));
                    *(u32x4*)(SG + off) = w;
                }
                asm volatile("" ::: "memory");
            }
    }
};

struct EpiMulAdd {
    static constexpr bool PERM = true, AFTER_DRAIN = false, WANTS_NEXT = false, PERMA = false;
    const bf16_t* SG; bf16_t* hb; float* outf;
    __device__ __forceinline__ void operator()(const f32x4 (&acc)[2][2][4][2], const Unit& u, int wr, int wc, int fr_in, int fq_in) const {
        int fr = fr_in, fq = fq_in; asm volatile("" : "+v"(fr), "+v"(fq));
#pragma unroll
        for (int ai = 0; ai < 2; ++ai)
#pragma unroll
            for (int m = 0; m < 4; ++m)
#pragma unroll
                for (int bj = 0; bj < 2; ++bj) {
                    const size_t off = (size_t)(u.pm * BM + ai * 128 + wr * 64 + m * 16 + fr) * DM + u.pn * BM + bj * HALF + wc * 32 + 8 * fq;
                    const u32x4 s = *(const u32x4*)(SG + off), q = *(const u32x4*)(hb + off);
                    const f32x4 s0 = {BF16_LO(s.x), BF16_HI(s.x), BF16_LO(s.y), BF16_HI(s.y)}, s1 = {BF16_LO(s.z), BF16_HI(s.z), BF16_LO(s.w), BF16_HI(s.w)};
                    const f32x4 b0 = {BF16_LO(q.x), BF16_HI(q.x), BF16_LO(q.y), BF16_HI(q.y)}, b1 = {BF16_LO(q.z), BF16_HI(q.z), BF16_LO(q.w), BF16_HI(q.w)};
                    const f32x4 h0 = b0 + acc[ai][bj][m][0] * s0, h1 = b1 + acc[ai][bj][m][1] * s1;
                    if (outf) { *(f32x4*)(outf + off) = h0; *(f32x4*)(outf + off + 4) = h1; }
                    else { u32x4 w; w.x = pk2(h0[0], h0[1]); w.y = pk2(h0[2], h0[3]); w.z = pk2(h1[0], h1[1]); w.w = pk2(h1[2], h1[3]); *(u32x4*)(hb + off) = w; }
                    if (bj == 1 && (m & 1)) asm volatile("" ::: "memory");
                }
    }
};

struct EpiUp {
    static constexpr bool PERM = false, AFTER_DRAIN = false, WANTS_NEXT = true, PERMA = true;
    bf16_t* A; const float* cw; const float* cb; float* edge; PG8_LAS float* xr; const u64_t* rsq; PG8_LAS float* prm; PG8_LAS float* rsd;
    __device__ __forceinline__ float ldp(int j, int pn) const { const int gv = j >> 9, tap = (j >> 7) & 3, col = gv * DFF + 128 * pn + (j & 127); return tap < 3 ? cw[tap * UPN + col] : cb[col]; }
#define DPPO(oldv, v, ctrl) __builtin_bit_cast(float, __builtin_amdgcn_update_dpp(__builtin_bit_cast(int, (float)(oldv)), __builtin_bit_cast(int, (float)(v)), (ctrl), 0xf, 0xf, false))
    __device__ __forceinline__ void run(const f32x4 (&acc)[2][2][4][2], const Unit& u, const Unit& nxt, bool has_next, int ui, int wr, int wc, int fr_in, int fq_in) const {
        int fr = fr_in, fq = fq_in; asm volatile("" : "+v"(fr), "+v"(fq));
        const int tid = (wr * 4 + wc) * 64 + fq * 16 + fr;
        const int slot = ui & 1;
        if (ui == 0) {
            prm[slot * 1024 + tid] = ldp(tid, u.pn); prm[slot * 1024 + tid + 512] = ldp(tid + 512, u.pn);
            if (tid < 256) rsd[slot * 256 + tid] = row_rstd(rsq, u.pm * BM + tid);
            PG8_EPI_BAR();
        }
        float nx0 = 0.f, nx1 = 0.f, nrs = 1.f;
        if (has_next) { nx0 = ldp(tid, nxt.pn); nx1 = ldp(tid + 512, nxt.pn); if (tid < 256) nrs = rsq_sum(rsq, nxt.pm * BM + tid); }
        float* eg = edge + (size_t)(u.pm * 22 + u.pn) * 1024;
        float rs[2][4];
#pragma unroll
        for (int ai = 0; ai < 2; ++ai)
#pragma unroll
            for (int m = 0; m < 4; ++m) rs[ai][m] = rsd[slot * 256 + ai * 128 + wr * 64 + 4 * fr + m];
#pragma unroll
        for (int bj = 0; bj < 2; ++bj)
#pragma unroll
            for (int n = 0; n < 2; ++n) {
                const int colt = bj * 128 + wc * 32 + n * 16 + 4 * fq;
                if (fr == 15) {
                    *(PG8_LAS f32x4*)(xr + ((0 + wr) * 2 + 0) * 256 + colt) = acc[0][bj][2][n] * rs[0][2]; *(PG8_LAS f32x4*)(xr + ((0 + wr) * 2 + 1) * 256 + colt) = acc[0][bj][3][n] * rs[0][3];
                    *(PG8_LAS f32x4*)(xr + ((2 + wr) * 2 + 0) * 256 + colt) = acc[1][bj][2][n] * rs[1][2]; *(PG8_LAS f32x4*)(xr + ((2 + wr) * 2 + 1) * 256 + colt) = acc[1][bj][3][n] * rs[1][3];
                    if (wr == 1) { *(f32x4*)(eg + 2 * 256 + colt) = acc[1][bj][2][n] * rs[1][2]; *(f32x4*)(eg + 3 * 256 + colt) = acc[1][bj][3][n] * rs[1][3]; }
                }
                if (wr == 0 && fr == 0) { *(f32x4*)(eg + colt) = acc[0][bj][0][n] * rs[0][0]; *(f32x4*)(eg + 256 + colt) = acc[0][bj][1][n] * rs[0][1]; }
            }
        PG8_EPI_BAR();
#pragma unroll
        for (int ai = 0; ai < 2; ++ai)
#pragma unroll
            for (int m = 0; m < 4; ++m) asm volatile("" : "+v"(rs[ai][m]));
#pragma unroll
        for (int n = 0; n < 2; ++n) {
            const int cl = wc * 32 + n * 16 + 4 * fq, ch = u.pn * 128 + cl;
            const PG8_LAS float* pp = prm + slot * 1024 + cl;
            const f32x4 wg0 = *(const PG8_LAS f32x4*)(pp), wg1 = *(const PG8_LAS f32x4*)(pp + 128), wg2 = *(const PG8_LAS f32x4*)(pp + 256), bg = *(const PG8_LAS f32x4*)(pp + 384);
            const f32x4 wv0 = *(const PG8_LAS f32x4*)(pp + 512), wv1 = *(const PG8_LAS f32x4*)(pp + 640), wv2 = *(const PG8_LAS f32x4*)(pp + 768), bv = *(const PG8_LAS f32x4*)(pp + 896);
#pragma unroll
            for (int ai = 0; ai < 2; ++ai) {
                const int grp = 2 * ai + wr;
                f32x4 hg2 = {0.f, 0.f, 0.f, 0.f}, hg3 = hg2, hv2 = hg2, hv3 = hg2;
                if (grp > 0 && fr == 0) { const PG8_LAS float* xp = xr + ((grp - 1) * 2) * 256 + cl;
                    hg2 = *(const PG8_LAS f32x4*)(xp); hg3 = *(const PG8_LAS f32x4*)(xp + 256); hv2 = *(const PG8_LAS f32x4*)(xp + 128); hv3 = *(const PG8_LAS f32x4*)(xp + 256 + 128); }
                f32x4 pg2, pg1, pv2, pv1;
                {
                    const f32x4 g2 = acc[ai][0][2][n] * rs[ai][2], g3 = acc[ai][0][3][n] * rs[ai][3], v2 = acc[ai][1][2][n] * rs[ai][2], v3 = acc[ai][1][3][n] * rs[ai][3];
#pragma unroll
                    for (int i = 0; i < 4; ++i) {
                        float a0 = g2[i], a1 = g3[i], a2 = v2[i], a3 = v3[i];
                        asm volatile("" : "+v"(a0), "+v"(a1), "+v"(a2), "+v"(a3));
                        const float t0 = DPPF(a0, 0x111), t1 = DPPF(a1, 0x111), t2 = DPPF(a2, 0x111), t3 = DPPF(a3, 0x111);
                        pg2[i] = t0 + hg2[i]; pg1[i] = t1 + hg3[i]; pv2[i] = t2 + hv2[i]; pv1[i] = t3 + hv3[i]; }
                }
#pragma unroll
                for (int m = 0; m < 4; ++m) {
                    const f32x4 gc = acc[ai][0][m][n] * rs[ai][m], vc = acc[ai][1][m][n] * rs[ai][m];
                    const f32x4 cgt = bg + wg0 * pg2 + wg1 * pg1 + wg2 * gc, cvl = bv + wv0 * pv2 + wv1 * pv1 + wv2 * vc;
                    float a[4];
#pragma unroll
                    for (int i = 0; i < 4; ++i) a[i] = cgt[i] * sigmoidf_(cgt[i]) * cvl[i];
                    u32x2 w; w.x = pk2(a[0], a[1]); w.y = pk2(a[2], a[3]);
                    *(u32x2*)(A + (size_t)(u.pm * BM + ai * 128 + wr * 64 + 4 * fr + m) * DFF + ch) = w;
                    pg2 = pg1; pg1 = gc; pv2 = pv1; pv1 = vc;
                }
                asm volatile("" ::: "memory");
            }
        }
        if (has_next) {
            prm[(slot ^ 1) * 1024 + tid] = nx0; prm[(slot ^ 1) * 1024 + tid + 512] = nx1;
            if (tid < 256) rsd[(slot ^ 1) * 256 + tid] = fast_rsq(nrs * (1.0f / DM) + EPS);
        }
    }
};
template <class Epi, class Sched, bool ALIGN_EPI = false, bool SP2 = false>
__device__ __forceinline__ void gemm_phase(PG8_LAS unsigned char* lds, const Gemm g, const Sched& S, const Epi& E, const int tid_arg) {
    int tid_l = tid_arg; asm volatile("" : "+v"(tid_l));
    const int tid = tid_l, wid = __builtin_amdgcn_readfirstlane(tid >> 6), lane = tid & 63, wr = wid >> 2, wc = wid & 3, fr = lane & 15, fq = lane >> 4;
    const int K = g.K, nt = K / BK;
    unsigned voffA[2], voffB[2];
#pragma unroll
    for (int i = 0; i < 2; ++i) { int R, C; stage_rc(tid * 16 + i * 8192, R, C); const int Rb = Epi::PERM ? ((R & ~31) + perm32(R & 31)) : R;
        const int Ra = Epi::PERMA ? ((R & ~63) + 4 * (R & 15) + ((R >> 4) & 3)) : R;
        voffA[i] = (unsigned)(Ra * K + C) * 2u; voffB[i] = (unsigned)(Rb * K + C) * 2u; }
    const size_t kstep = (size_t)(BK * 2);
    const size_t hstep = (size_t)HALF * K * 2;
    const size_t tstep = 2 * hstep;
    const unsigned ldsw = (unsigned)wid * 1024u;
    const int aoff = lds_byte(wr * 64 + fr, fq * 8), boff = lds_byte(wc * 32 + fr, fq * 8);
#define PG8_SA(b, h) (((b) * 2 + (h)) * HTB)
#define PG8_SB(b, h) ((4 + (b) * 2 + (h)) * HTB)
#define PG8_STAGE(bufoff, gbase, voff) do { _Pragma("unroll") for (int _i = 0; _i < 2; ++_i) \
        __builtin_amdgcn_global_load_lds((const unsigned*)((const char*)(gbase) + (voff)[_i]), (PG8_LAS unsigned*)(lds + (bufoff) + ldsw + _i * 8192), 16, 0, 0); } while (0)
#define PG8_LDA(dst, b, h) do { _Pragma("unroll") for (int m = 0; m < 4; ++m) _Pragma("unroll") for (int k = 0; k < 2; ++k) dst[m][k] = *(const PG8_LAS bf16x8*)(lds + PG8_SA(b, h) + aoff + m * 2048 + k * 1024); } while (0)
#define PG8_LDB(dst, b, h) do { _Pragma("unroll") for (int n = 0; n < 2; ++n) _Pragma("unroll") for (int k = 0; k < 2; ++k) dst[n][k] = *(const PG8_LAS bf16x8*)(lds + PG8_SB(b, h) + boff + n * 2048 + k * 1024); } while (0)
#define PG8_MMA(ai, bj, At, Bt) do { __builtin_amdgcn_s_setprio(1); _Pragma("unroll") for (int m = 0; m < 4; ++m) _Pragma("unroll") for (int n = 0; n < 2; ++n) _Pragma("unroll") for (int k = 0; k < 2; ++k) \
        acc[ai][bj][m][n] = __builtin_amdgcn_mfma_f32_16x16x32_bf16(Bt[n][k], At[m][k], acc[ai][bj][m][n], 0, 0, 0); __builtin_amdgcn_s_setprio(0); } while (0)
#define PG8_WAIT_V(n) asm volatile("s_waitcnt vmcnt(" #n ")" ::: "memory")
#define PG8_WAIT_L(n) asm volatile("s_waitcnt lgkmcnt(" #n ")" ::: "memory")
#define PG8_BAR __builtin_amdgcn_s_barrier()
#define PG8_SCHED __builtin_amdgcn_sched_barrier(0)
    Unit cur, nxt; int ui = 0;
    if (!S.next(0, cur)) return;
    f32x4 acc[2][2][4][2];
#pragma unroll
    for (int a = 0; a < 2; ++a)
#pragma unroll
        for (int b = 0; b < 2; ++b)
#pragma unroll
            for (int m = 0; m < 4; ++m)
#pragma unroll
                for (int n = 0; n < 2; ++n) acc[a][b][m][n] = (f32x4){0.f, 0.f, 0.f, 0.f};
    bf16x8 At[4][2], B0[2][2], B1[2][2];
    const char* cA = (const char*)g.A + (size_t)cur.pm * tstep; const char* cB = (const char*)g.Bt + (size_t)cur.pn * tstep;
    S.a_ready(cur);
    if constexpr (SP2) {
        PG8_STAGE(PG8_SB(0, 0), cB, voffB); PG8_STAGE(PG8_SB(0, 1), cB + hstep, voffB); PG8_STAGE(PG8_SA(0, 0), cA, voffA); PG8_STAGE(PG8_SA(0, 1), cA + hstep, voffA);
        if (wr == 1) PG8_BAR;
        PG8_WAIT_V(2); PG8_BAR;
        PG8_STAGE(PG8_SB(1, 0), cB + kstep, voffB); PG8_STAGE(PG8_SA(1, 0), cA + kstep, voffA); PG8_STAGE(PG8_SB(1, 1), cB + hstep + kstep, voffB);
        PG8_WAIT_V(6); PG8_BAR;
    } else {
        PG8_STAGE(PG8_SB(0, 0), cB, voffB); PG8_STAGE(PG8_SA(0, 0), cA, voffA); PG8_STAGE(PG8_SB(0, 1), cB + hstep, voffB); PG8_STAGE(PG8_SA(0, 1), cA + hstep, voffA);
        if (wr == 1) PG8_BAR;
        PG8_WAIT_V(4); PG8_BAR;
        PG8_STAGE(PG8_SB(1, 0), cB + kstep, voffB); PG8_STAGE(PG8_SA(1, 0), cA + kstep, voffA); PG8_STAGE(PG8_SB(1, 1), cB + hstep + kstep, voffB);
        PG8_WAIT_V(6); PG8_BAR;
    }
    for (;;) {
        const bool has_next = S.next(ui + 1, nxt);
        const char* nA = has_next ? (const char*)g.A + (size_t)nxt.pm * tstep : cA; const char* nB = has_next ? (const char*)g.Bt + (size_t)nxt.pn * tstep : cB;
        for (int t = 0; t < nt; t += 2) {
            const bool last = (t == nt - 2);
            const char* a1 = cA + (size_t)(t + 1) * kstep;
            const char* a2 = last ? nA : cA + (size_t)(t + 2) * kstep; const char* b2 = last ? nB : cB + (size_t)(t + 2) * kstep;
            const char* a3 = a2 + kstep; const char* b3 = b2 + kstep;
            if (last && has_next) S.a_ready(nxt);
            if constexpr (SP2) {
            PG8_LDB(B0, 0, 0); PG8_LDB(B1, 0, 1); PG8_SCHED; PG8_LDA(At, 0, 0); PG8_STAGE(PG8_SA(1, 1), a1 + hstep, voffA);
            PG8_WAIT_V(8); PG8_WAIT_L(0); PG8_BAR; PG8_MMA(0, 0, At, B0); PG8_MMA(0, 1, At, B1); PG8_BAR; PG8_SCHED;
            PG8_LDA(At, 0, 1); PG8_STAGE(PG8_SB(0, 0), b2, voffB); PG8_STAGE(PG8_SB(0, 1), b2 + hstep, voffB); PG8_STAGE(PG8_SA(0, 0), a2, voffA);
            PG8_WAIT_V(8); PG8_WAIT_L(0); PG8_BAR; PG8_MMA(1, 0, At, B0); PG8_MMA(1, 1, At, B1); PG8_BAR; PG8_SCHED;
            PG8_LDB(B0, 1, 0); PG8_LDB(B1, 1, 1); PG8_SCHED; PG8_LDA(At, 1, 0); PG8_STAGE(PG8_SA(0, 1), a2 + hstep, voffA);
            PG8_WAIT_V(8); PG8_WAIT_L(0); PG8_BAR; PG8_MMA(0, 0, At, B0); PG8_MMA(0, 1, At, B1); PG8_BAR; PG8_SCHED;
            PG8_LDA(At, 1, 1); PG8_STAGE(PG8_SB(1, 0), b3, voffB); PG8_STAGE(PG8_SB(1, 1), b3 + hstep, voffB); PG8_STAGE(PG8_SA(1, 0), a3, voffA);
            PG8_WAIT_V(8); PG8_WAIT_L(0); PG8_BAR; PG8_MMA(1, 0, At, B0); PG8_MMA(1, 1, At, B1); PG8_BAR; PG8_SCHED;
            } else {
            PG8_LDB(B0, 0, 0); PG8_SCHED; PG8_LDA(At, 0, 0); PG8_STAGE(PG8_SA(1, 1), a1 + hstep, voffA);
            PG8_WAIT_L(8); PG8_BAR; PG8_WAIT_L(0); PG8_MMA(0, 0, At, B0); PG8_BAR; PG8_SCHED;
            PG8_LDB(B1, 0, 1); PG8_STAGE(PG8_SB(0, 0), b2, voffB);
            PG8_BAR; PG8_WAIT_L(0); PG8_MMA(0, 1, At, B1); PG8_BAR;
            PG8_LDA(At, 0, 1); PG8_STAGE(PG8_SA(0, 0), a2, voffA);
            PG8_BAR; PG8_WAIT_L(0); PG8_MMA(1, 0, At, B0); PG8_BAR; PG8_SCHED;
            PG8_STAGE(PG8_SB(0, 1), b2 + hstep, voffB);
            PG8_WAIT_V(6); PG8_BAR; PG8_MMA(1, 1, At, B1); PG8_BAR;
            PG8_LDB(B0, 1, 0); PG8_SCHED; PG8_LDA(At, 1, 0); PG8_STAGE(PG8_SA(0, 1), a2 + hstep, voffA);
            PG8_WAIT_L(8); PG8_BAR; PG8_WAIT_L(0); PG8_MMA(0, 0, At, B0); PG8_BAR; PG8_SCHED;
            PG8_LDB(B1, 1, 1); PG8_STAGE(PG8_SB(1, 0), b3, voffB);
            PG8_BAR; PG8_WAIT_L(0); PG8_MMA(0, 1, At, B1); PG8_BAR;
            PG8_LDA(At, 1, 1); PG8_STAGE(PG8_SA(1, 0), a3, voffA);
            PG8_BAR; PG8_WAIT_L(0); PG8_MMA(1, 0, At, B0); PG8_BAR; PG8_SCHED;
            PG8_STAGE(PG8_SB(1, 1), b3 + hstep, voffB);
            PG8_WAIT_V(6); PG8_BAR; PG8_MMA(1, 1, At, B1); PG8_BAR;
            }
        }
        if constexpr (ALIGN_EPI) { if (wr == 0) PG8_BAR; }
        if constexpr (!Epi::AFTER_DRAIN) { if constexpr (Epi::WANTS_NEXT) E.run(acc, cur, nxt, has_next, ui, wr, wc, fr, fq); else E(acc, cur, wr, wc, fr, fq); S.done(cur); }
        if (!has_next) break;
#pragma unroll
        for (int a = 0; a < 2; ++a)
#pragma unroll
            for (int b = 0; b < 2; ++b)
#pragma unroll
                for (int m = 0; m < 4; ++m)
#pragma unroll
                    for (int n = 0; n < 2; ++n) acc[a][b][m][n] = (f32x4){0.f, 0.f, 0.f, 0.f};
        cur = nxt; cA = nA; cB = nB; ++ui;
        if constexpr (ALIGN_EPI) { if (wr == 1) PG8_BAR; }
    }
    PG8_WAIT_V(0);
    if constexpr (!ALIGN_EPI) { if (wr == 0) PG8_BAR; }
    PG8_BAR;
    if constexpr (Epi::AFTER_DRAIN) { E.fused(acc, cur, wr, wc, fr, fq, lds, wid, lane); S.done(cur); }
#undef PG8_SA
#undef PG8_SB
#undef PG8_STAGE
#undef PG8_LDA
#undef PG8_LDB
#undef PG8_MMA
#undef PG8_WAIT_V
#undef PG8_WAIT_L
#undef PG8_BAR
#undef PG8_SCHED
}
}
template <int MODE> __device__ __forceinline__ int srccol(int n) {
    if (MODE == 1) {
        const int ct = n & 255, lg = (n & ~255) + ((ct >> 5) & 3) * 64 + (ct >> 7) * 32 + (ct & 31);
        return lg < 2432 ? lg : lg + 6; }
    if (MODE == 2) { const int pn = n >> 8, j = n & 255; return j < 128 ? 128 * pn + j : DFF + 128 * pn + (j - 128); }
    return n;
}
template <int MODE> __device__ __forceinline__ void transpose_item(const float* W, int K, int Nsrc, int Ndst, bf16_t* WT, LAS float* scr, int item, int lane, const float* kgain = nullptr) {
    const int nblk = Ndst / 32, kb = item / nblk, nb = item % nblk, k0 = 64 * kb, n0 = 32 * nb;
    const int sc = srccol<MODE>(n0 + (lane & 31));
#pragma unroll
    for (int i = 0; i < 32; ++i) { const int kk = 2 * i + (lane >> 5); scr[kk * 33 + (lane & 31)] = W[(size_t)(k0 + kk) * Nsrc + sc] * (kgain ? kgain[k0 + kk] : 1.0f); }
    asm volatile("s_waitcnt lgkmcnt(0)" ::: "memory");
    const int c = lane & 7;
#pragma unroll
    for (int j = 0; j < 4; ++j) { const int n = (lane >> 3) + 8 * j; const LAS float* s = scr + (8 * c) * 33 + n;
        u32x4 o; o.x = pk2(s[0 * 33], s[1 * 33]); o.y = pk2(s[2 * 33], s[3 * 33]); o.z = pk2(s[4 * 33], s[5 * 33]); o.w = pk2(s[6 * 33], s[7 * 33]);
        *(u32x4*)(WT + (size_t)(n0 + n) * K + k0 + 8 * c) = o; }
    asm volatile("s_waitcnt lgkmcnt(0)" ::: "memory");
}

template <bool FG, bool BIN = false> __device__ __forceinline__ void norm_phase(const float* hin, const float* gain, bf16_t* out, const float* win, const float* fbias, float* logf, int gw, int NGW, int lane) {
    float g[16];
#pragma unroll
    for (int i = 0; i < 2; ++i) { const int c0 = 8 * (lane + 64 * i); const f32x4 a = *(const f32x4*)(gain + c0), b = *(const f32x4*)(gain + c0 + 4);
        g[8 * i + 0] = a[0]; g[8 * i + 1] = a[1]; g[8 * i + 2] = a[2]; g[8 * i + 3] = a[3]; g[8 * i + 4] = b[0]; g[8 * i + 5] = b[1]; g[8 * i + 6] = b[2]; g[8 * i + 7] = b[3]; }
    float wf[6][16]; float fb[6];
    if (FG) {
#pragma unroll
        for (int i = 0; i < 2; ++i)
#pragma unroll
            for (int e = 0; e < 8; ++e) { const float* wp = win + (size_t)(8 * (lane + 64 * i) + e) * INC + 2432;
#pragma unroll
                for (int j = 0; j < 6; ++j) wf[j][8 * i + e] = wp[j] * g[8 * i + e]; }
#pragma unroll
        for (int j = 0; j < 6; ++j) fb[j] = fbias[j];
    }
    f32x4 nx[4];
    const bf16_t* hbin = (const bf16_t*)hin;
#define NORM_LD(rowi) do { _Pragma("unroll") for (int i = 0; i < 2; ++i) { const int c0 = 8 * (lane + 64 * i); \
        if (BIN) { const u32x4 q_ = *(const u32x4*)(hbin + (size_t)(rowi) * DM + c0); \
            nx[2 * i] = (f32x4){__uint_as_float(q_.x << 16), __uint_as_float(q_.x & 0xffff0000u), __uint_as_float(q_.y << 16), __uint_as_float(q_.y & 0xffff0000u)}; \
            nx[2 * i + 1] = (f32x4){__uint_as_float(q_.z << 16), __uint_as_float(q_.z & 0xffff0000u), __uint_as_float(q_.w << 16), __uint_as_float(q_.w & 0xffff0000u)}; } \
        else { nx[2 * i] = *(const f32x4*)(hin + (size_t)(rowi) * DM + c0); nx[2 * i + 1] = *(const f32x4*)(hin + (size_t)(rowi) * DM + c0 + 4); } } } while (0)
    if (gw < T) NORM_LD(gw);
    for (int row = gw; row < T; row += NGW) {
        float x[16];
#pragma unroll
        for (int i = 0; i < 4; ++i) { x[4 * i + 0] = nx[i][0]; x[4 * i + 1] = nx[i][1]; x[4 * i + 2] = nx[i][2]; x[4 * i + 3] = nx[i][3]; }
        if (row + NGW < T) NORM_LD(row + NGW);
        float ss = 0.f;
#pragma unroll
        for (int e = 0; e < 16; ++e) ss += x[e] * x[e];
        ss = wave_sum(ss);
        const float rstd = fast_rsq(ss * (1.0f / DM) + EPS);
#pragma unroll
        for (int i = 0; i < 2; ++i) { u32x4 w;
            w.x = pk2(x[8 * i + 0] * rstd * g[8 * i + 0], x[8 * i + 1] * rstd * g[8 * i + 1]); w.y = pk2(x[8 * i + 2] * rstd * g[8 * i + 2], x[8 * i + 3] * rstd * g[8 * i + 3]);
            w.z = pk2(x[8 * i + 4] * rstd * g[8 * i + 4], x[8 * i + 5] * rstd * g[8 * i + 5]); w.w = pk2(x[8 * i + 6] * rstd * g[8 * i + 6], x[8 * i + 7] * rstd * g[8 * i + 7]);
            *(u32x4*)(out + (size_t)row * DM + 8 * (lane + 64 * i)) = w; }
        if (FG) {
            float mine = 0.f;
#pragma unroll
            for (int j = 0; j < 6; ++j) { float d = 0.f;
#pragma unroll
                for (int e = 0; e < 16; ++e) d += x[e] * wf[j][e];
                d = wave_sum(d) * rstd + fb[j];
                if (lane == j) mine = d; }
            if (lane < 6) { const float v = mine; logf[(size_t)row * 6 + lane] = fminf(v, 0.f) - log1pf(expf(-fabsf(v))); }
        }
    }
}

__device__ __forceinline__ void scan_unit(const float* logf, float* F2, int bh, LAS double* sd, int tid) {
    const int b = bh / 6, h = bh % 6;
    const float* src = logf + (size_t)b * SEQ * 6 + h;
    double loc[8]; double run = 0.0;
#pragma unroll
    for (int i = 0; i < 8; ++i) { run += (double)src[(size_t)(8 * tid + i) * 6]; loc[i] = run; }
    sd[tid] = run;
    __syncthreads();
    if (tid < 64) {
        double v[8], tot = 0.0;
#pragma unroll
        for (int k = 0; k < 8; ++k) { v[k] = tot; tot += sd[8 * tid + k]; }
        double inc = tot;
#pragma unroll
        for (int o = 1; o < 64; o <<= 1) {
            const int src = (tid >= o) ? tid - o : tid;
            const unsigned long long u_ = __builtin_bit_cast(unsigned long long, inc);
            const unsigned lo_ = (unsigned)__builtin_amdgcn_ds_bpermute(src << 2, (int)(unsigned)u_), hi_ = (unsigned)__builtin_amdgcn_ds_bpermute(src << 2, (int)(unsigned)(u_ >> 32));
            const double up = __builtin_bit_cast(double, ((unsigned long long)hi_ << 32) | lo_);
            if (tid >= o) inc += up;
        }
        const double base = inc - tot;
#pragma unroll
        for (int k = 0; k < 8; ++k) sd[8 * tid + k] = base + v[k];
    }
    __syncthreads();
    const double off = sd[tid];
#pragma unroll
    for (int i = 0; i < 8; ++i) F2[(size_t)bh * SEQ + 8 * tid + i] = (float)((off + loc[i]) * 1.4426950408889634);
    __syncthreads();
}

__device__ __forceinline__ void fix_rows(bf16_t* A, const float* edge, const float* cw, const float* cb, int pm, int tid) {
    const bool hasprev = (pm & 15) != 0;
#pragma unroll
    for (int it_ = 0; it_ < 6; ++it_) {
        const int ch = tid + 512 * it_; if (ch >= DFF) break;
        const int pn = ch >> 7, ci = ch & 127;
        const float* E = edge + (size_t)(pm * 22 + pn) * 1024;
        const float* P = hasprev ? edge + (size_t)((pm - 1) * 22 + pn) * 1024 : E;
        float c0[2], c1[2];
#pragma unroll
        for (int gv = 0; gv < 2; ++gv) {
            const int col = gv * 128 + ci, cc = gv * DFF + ch;
            const float u0 = E[col], u1 = E[256 + col], p254 = hasprev ? P[512 + col] : 0.f, p255 = hasprev ? P[768 + col] : 0.f;
            const float w0 = cw[cc], w1 = cw[UPN + cc], w2 = cw[2 * UPN + cc], bb = cb[cc];
            c0[gv] = bb + w0 * p254 + w1 * p255 + w2 * u0; c1[gv] = bb + w0 * p255 + w1 * u0 + w2 * u1;
        }
        const float a0 = c0[0] * sigmoidf_(c0[0]) * c0[1], a1 = c1[0] * sigmoidf_(c1[0]) * c1[1];
        A[(size_t)(pm * 256) * DFF + ch] = (bf16_t)(pk2(a0, 0.f) & 0xffffu);
        A[(size_t)(pm * 256 + 1) * DFF + ch] = (bf16_t)(pk2(a1, 0.f) & 0xffffu);
    }
}

struct AttnCtx { const bf16_t* Z; bf16_t* O; const float* F2; const float* rel; const float* subln; float lam, oml, Mb0, Mb1, Mb2; };
__device__ __forceinline__ int crow(int r, int hi) { return (r & 3) + 8 * (r >> 2) + 4 * hi; }
#define MFMA32(a, b, c) __builtin_amdgcn_mfma_f32_32x32x16_bf16((a), (b), (c), 0, 0, 0)
typedef short v4i16_t __attribute__((ext_vector_type(4)));
__device__ __forceinline__ s16x4 vtr(const LAS unsigned char* p) { return __builtin_bit_cast(s16x4, __builtin_amdgcn_ds_read_tr16_b64_v4i16((LAS v4i16_t*)p)); }

constexpr int AL_K = 0, AL_V = 32768, AL_F = 65536, AL_REL = 66560, AL_WS = 68608, AL_U = 69632;

template <int TYPE> __device__ __forceinline__ void attn_unit(const AttnCtx& C, int b, int h, int qb, LAS unsigned char* lds, int tid_in, unsigned* counter) {
    int tid = tid_in; asm volatile("" : "+v"(tid));
    const int lane = tid & 63, w = __builtin_amdgcn_readfirstlane(tid >> 6), r32 = lane & 31, hi = lane >> 5;
    const int cq = 4 * qb + (w >> 1);
    const float sl2 = (TYPE == 0) ? exp2f(-2.0f * (float)(h + 1)) * LOG2E : 0.f;
    const float dmax = (TYPE == 0) ? (160.0f + C.Mb0) / sl2 : 0.f;
    int t0 = 0; const int t1 = 4 * qb + 4;
    if (TYPE == 2) t0 = (4 * qb - 8 > 0) ? 4 * qb - 8 : 0;
    if (TYPE == 0) { const float num = (float)(256 * qb - 63) - dmax; if (num >= 0.f) t0 = (int)(num * (1.0f / 64.0f)) + 1; }
    int tfirst = 0;
    if (TYPE == 1) {
        const float* f2t = C.F2 + (size_t)(b * 6 + h) * SEQ;
        const float fend = f2t[64 * lane + 63];
        const float fq_unit = f2t[256 * qb], fq_wave = f2t[256 * qb + 32 * w];
        const unsigned long long need_u = __ballot(fq_unit - fend > -160.0f), need_w = __ballot(fq_wave - fend > -160.0f);
        t0 = need_u ? (int)__builtin_ctzll(need_u) : 0; tfirst = need_w ? (int)__builtin_ctzll(need_w) : 0;
        if (t0 > 4 * qb) t0 = 4 * qb;
    }
    t0 &= ~1;
    const int sq = 256 * qb + 32 * w + r32;
    const size_t rowb = (size_t)b * SEQ;
    LAS unsigned char* Kb = lds + AL_K; LAS unsigned char* Vb = lds + AL_V;
    LAS float* Fb = (LAS float*)(lds + AL_F); LAS float* relb = (LAS float*)(lds + AL_REL); LAS float* wscr = (LAS float*)(lds + AL_WS) + w * 32;
    constexpr int NPASS = (TYPE == 0) ? 2 : 1;
    unsigned nclaim = 0u;
    const float Mb = (TYPE == 0) ? C.Mb0 : (TYPE == 1) ? C.Mb1 : C.Mb2;
    const int kwoff = w * 1024 + lane * 16, vwoff = ((tid & 7) >> 2) * 4096 + (tid >> 3) * 64 + (tid & 3) * 16;
    const int vb0 = ((lane >> 4) & 1) * 32 + (lane & 3) * 8 + (4 * hi + ((lane & 15) >> 2)) * 64;
    f32x16 o[2], o1[2];
    if (TYPE == 2) { for (int i = tid; i < 257; i += 512) relb[i] = C.rel[h * 257 + i] * LOG2E; }
#pragma unroll
    for (int pass = 0; pass < NPASS; ++pass) {
        int qcol, kcol, vcol;
        if (TYPE == 0) { qcol = pass * 256 + 64 * h; kcol = 512 + pass * 256 + 64 * h; vcol = 1024 + 64 * h; }
        else if (TYPE == 1) { qcol = 1280 + 64 * h; kcol = 1664 + 64 * h; vcol = 2048 + 64 * h; }
        else { qcol = 2432 + 64 * h; kcol = 2816 + 64 * h; vcol = 3200 + 64 * h; }
        const bf16_t* Qp = C.Z + (rowb + sq) * ZP + qcol + 8 * hi;
        bf16x8 qr[4];
#pragma unroll
        for (int d0 = 0; d0 < 4; ++d0) qr[d0] = *(const bf16x8*)(Qp + 16 * d0);
        float cinit = -Mb;
        const float* f2p = C.F2 + (size_t)(b * 6 + h) * SEQ;
        if (TYPE == 1) cinit += f2p[sq];
        f32x16 cvec, zvec;
#pragma unroll
        for (int r = 0; r < 16; ++r) { cvec[r] = cinit; zvec[r] = 0.f; }
#pragma unroll
        for (int r = 0; r < 16; ++r) { o[0][r] = 0.f; o[1][r] = 0.f; }
        float lsum = 0.f;
        const bf16_t* kg = C.Z + (rowb + lane) * ZP + kcol + 8 * w;
        const bf16_t* vg = C.Z + (rowb + (tid >> 3)) * ZP + vcol + 8 * (tid & 7);
        u32x4 kreg = *(const u32x4*)(kg + (size_t)t0 * 64 * ZP), vreg = *(const u32x4*)(vg + (size_t)t0 * 64 * ZP);
        u32x4 kreg2 = *(const u32x4*)(kg + (size_t)(t0 + 1) * 64 * ZP), vreg2 = *(const u32x4*)(vg + (size_t)(t0 + 1) * 64 * ZP);
        float freg = 0.f, freg2 = 0.f;
        if (TYPE == 1 && tid < 64) { freg = f2p[t0 * 64 + tid]; freg2 = f2p[(t0 + 1) * 64 + tid]; }
        __syncthreads();
        for (int t = t0; t < t1; ++t) {
            const int bo = (t & 3) * 8192;
            if ((t & 1) == 0) {
                const int bo1 = ((t + 1) & 3) * 8192;
                *(LAS u32x4*)(Kb + bo + kwoff) = kreg; *(LAS u32x4*)(Vb + bo + vwoff) = vreg;
                *(LAS u32x4*)(Kb + bo1 + kwoff) = kreg2; *(LAS u32x4*)(Vb + bo1 + vwoff) = vreg2;
                if (TYPE == 1 && tid < 64) { Fb[(t & 3) * 64 + tid] = freg; Fb[((t + 1) & 3) * 64 + tid] = freg2; }
                if (t + 2 < t1) {
                    kreg = *(const u32x4*)(kg + (size_t)(t + 2) * 64 * ZP); vreg = *(const u32x4*)(vg + (size_t)(t + 2) * 64 * ZP);
                    kreg2 = *(const u32x4*)(kg + (size_t)(t + 3) * 64 * ZP); vreg2 = *(const u32x4*)(vg + (size_t)(t + 3) * 64 * ZP);
                    if (TYPE == 1 && tid < 64) { freg = f2p[(t + 2) * 64 + tid]; freg2 = f2p[(t + 3) * 64 + tid]; }
                }
                if (pass == NPASS - 1 && t + 2 >= t1 && tid == 0) nclaim = atomicAdd(counter, 1u);
                __syncthreads();
            }
            const bool active = (TYPE == 2) ? (t >= cq - 8 && t <= cq) : (TYPE == 0) ? (t <= cq && (float)(256 * qb + 32 * w - 64 * t - 63) < dmax) : (t <= cq && t >= tfirst);
            if (active) {
                f32x16 p0, p1;
                const LAS unsigned char* kp = Kb + bo + hi * 1024 + r32 * 16;
#pragma unroll
                for (int d0 = 0; d0 < 4; ++d0) {
                    const bf16x8 a0 = *(const LAS bf16x8*)(kp + d0 * 2048), a1 = *(const LAS bf16x8*)(kp + d0 * 2048 + 512);
                    if (d0 == 0) { p0 = MFMA32(a0, qr[0], (TYPE == 1 ? cvec : zvec)); p1 = MFMA32(a1, qr[0], (TYPE == 1 ? cvec : zvec)); }
                    else { p0 = MFMA32(a0, qr[d0], p0); p1 = MFMA32(a1, qr[d0], p1); }
                }
                const int xi = sq - 64 * t - 4 * hi;
                if (TYPE == 0) {
                    const float xf = (float)xi;
#pragma unroll
                    for (int r = 0; r < 16; ++r) { const float c = (float)((r & 3) + 8 * (r >> 2));
                        p0[r] = fast_exp2(p0[r] - sl2 * fabsf(xf - c)); p1[r] = fast_exp2(p1[r] - sl2 * fabsf(xf - (c + 32.f))); }
                } else if (TYPE == 1) {
                    const LAS float* fp = Fb + (t & 3) * 64 + 4 * hi;
#pragma unroll
                    for (int g = 0; g < 4; ++g) { const f32x4 fa = *(const LAS f32x4*)(fp + 8 * g), fb2 = *(const LAS f32x4*)(fp + 32 + 8 * g);
#pragma unroll
                        for (int i = 0; i < 4; i += 2) {
                            const f32x2_t d0_ = (f32x2_t){p0[4 * g + i], p0[4 * g + i + 1]} - (f32x2_t){fa[i], fa[i + 1]}, d1_ = (f32x2_t){p1[4 * g + i], p1[4 * g + i + 1]} - (f32x2_t){fb2[i], fb2[i + 1]};
                            p0[4 * g + i] = fast_exp2(d0_[0]); p0[4 * g + i + 1] = fast_exp2(d0_[1]); p1[4 * g + i] = fast_exp2(d1_[0]); p1[4 * g + i + 1] = fast_exp2(d1_[1]); } }
                    if (t == cq) { const int qrel = 32 * (w & 1) + r32;
#pragma unroll
                        for (int r = 0; r < 16; ++r) { const int kv = crow(r, hi); if (kv > qrel) p0[r] = 0.f; if (kv + 32 > qrel) p1[r] = 0.f; } }
                } else {
                    if (cq - t >= 3) { const float bc = relb[256];
#pragma unroll
                        for (int r = 0; r < 16; ++r) { p0[r] = fast_exp2(p0[r] + bc); p1[r] = fast_exp2(p1[r] + bc); }
                    } else {
#pragma unroll
                        for (int r = 0; r < 16; ++r) { const int c = (r & 3) + 8 * (r >> 2);
                            int i0 = xi - c; i0 = i0 < -128 ? -128 : (i0 > 128 ? 128 : i0); int i1 = xi - c - 32; i1 = i1 < -128 ? -128 : (i1 > 128 ? 128 : i1);
                            p0[r] = fast_exp2(p0[r] + relb[i0 + 128]); p1[r] = fast_exp2(p1[r] + relb[i1 + 128]); }
                    }
                }
                f32x2_t a2 = {0.f, 0.f};
#pragma unroll
                for (int r = 0; r < 16; r += 2) { a2 += (f32x2_t){p0[r], p0[r + 1]}; a2 += (f32x2_t){p1[r], p1[r + 1]}; }
                lsum += a2[0] + a2[1];
                bf16x8 pa[4];
#pragma unroll
                for (int s = 0; s < 2; ++s) {
                    u32x4 a, c2;
                    a.x = pk2(p0[8 * s + 0], p0[8 * s + 1]); a.y = pk2(p0[8 * s + 2], p0[8 * s + 3]); a.z = pk2(p0[8 * s + 4], p0[8 * s + 5]); a.w = pk2(p0[8 * s + 6], p0[8 * s + 7]);
                    c2.x = pk2(p1[8 * s + 0], p1[8 * s + 1]); c2.y = pk2(p1[8 * s + 2], p1[8 * s + 3]); c2.z = pk2(p1[8 * s + 4], p1[8 * s + 5]); c2.w = pk2(p1[8 * s + 6], p1[8 * s + 7]);
                    pa[s] = __builtin_bit_cast(bf16x8, a); pa[2 + s] = __builtin_bit_cast(bf16x8, c2);
                }
                const LAS unsigned char* vp = Vb + bo + vb0;
#pragma unroll
                for (int dh = 0; dh < 2; ++dh)
#pragma unroll
                    for (int ks = 0; ks < 4; ++ks) {
                        const s16x4 lo = vtr(vp + dh * 4096 + ks * 1024), hh = vtr(vp + dh * 4096 + ks * 1024 + 512);
                        const bf16x8 vf = {lo[0], lo[1], lo[2], lo[3], hh[0], hh[1], hh[2], hh[3]};
                        o[dh] = MFMA32(pa[ks], vf, o[dh]);
                    }
            }
        }
        const float ltot = xor32_sum(lsum);
        if (hi == 0) wscr[r32] = 1.0f / ltot;
#pragma unroll
        for (int g = 0; g < 4; ++g) { const f32x4 iv = *(const LAS f32x4*)(wscr + 8 * g + 4 * hi);
#pragma unroll
            for (int i = 0; i < 4; ++i) { o[0][4 * g + i] *= iv[i]; o[1][4 * g + i] *= iv[i]; } }
        if (TYPE == 0) {
            if (pass == 0) { o1[0] = o[0]; o1[1] = o[1]; }
            else {
#pragma unroll
                for (int r = 0; r < 16; ++r) { o[0][r] = o1[0][r] - C.lam * o[0][r]; o[1][r] = o1[1][r] - C.lam * o[1][r]; }
            }
        }
    }
    int ocol;
    if (TYPE == 0) {
        ocol = 64 * h;
        const float g0 = C.subln[r32], g1 = C.subln[32 + r32];
#pragma unroll
        for (int r = 0; r < 16; ++r) {
            float ss = o[0][r] * o[0][r] + o[1][r] * o[1][r];
            ss = xor16_sum(row16_sum(ss));
            const float rs = C.oml * fast_rsq(ss * (1.0f / 64.0f) + EPS);
            o[0][r] *= rs * g0; o[1][r] *= rs * g1;
        }
    } else if (TYPE == 1) ocol = 256 + 64 * h; else ocol = 640 + 64 * h;
    bf16_t* Op = C.O + (rowb + 256 * qb + 32 * w) * DM + ocol + r32;
#pragma unroll
    for (int r = 0; r < 16; ++r) {
        const size_t ro = (size_t)crow(r, hi) * DM;
        Op[ro] = (bf16_t)(pk2(o[0][r], 0.f) & 0xffffu); Op[ro + 32] = (bf16_t)(pk2(o[1][r], 0.f) & 0xffffu);
    }
    if (tid == 0) ((LAS unsigned*)(lds + AL_U))[0] = nclaim;
}

constexpr int ATT_UNITS = 2048;
__device__ __forceinline__ void attn_phase(const AttnCtx& C, unsigned* counter, LAS unsigned char* lds, int tid) {
    LAS unsigned* ub = (LAS unsigned*)(lds + AL_U);
    __syncthreads();
    if (tid == 0) ub[0] = atomicAdd(counter, 1u);
    for (;;) {
        __syncthreads();
        const int u = (int)ub[0];
        if (u >= ATT_UNITS) break;
        int ty, ub_, uh, uq;
        if (u < 256) { ty = 0; ub_ = (u & 31) >> 2; uh = u & 3; uq = 15 - (u >> 5); }
        else if (u < 1280) { const int v = u - 256, q = 7 - (v >> 7), wv = v & 127;
            if (wv < 32) { ty = 0; ub_ = wv >> 2; uh = wv & 3; uq = q; }
            else if (wv < 80) { ty = 1; ub_ = (wv - 32) / 6; uh = (wv - 32) % 6; uq = 2 * q + 1; }
            else { ty = 1; ub_ = (wv - 80) / 6; uh = (wv - 80) % 6; uq = 2 * q; } }
        else { const int v = u - 1280; ty = 2; ub_ = (v % 48) / 6; uh = (v % 48) % 6; uq = 15 - v / 48; }
        if (ty == 0) attn_unit<0>(C, ub_, uh, uq, lds, tid, counter);
        else if (ty == 1) attn_unit<1>(C, ub_, uh, uq, lds, tid, counter);
        else attn_unit<2>(C, ub_, uh, uq, lds, tid, counter);
    }
}
struct Args { const float* in[18]; float* out; unsigned char* ws; };
constexpr int LDS_TOTAL = 149760, LDS_XCH = 131072, LDS_PRM = LDS_XCH + 8256, LDS_RSD = LDS_PRM + 8192;
#ifdef PROBE_SYNC2
#define GSYNC() do { xcd_barrier(xbar, K_TID == 0); xcd_barrier(xbar, K_TID == 0); } while (0)
#else
#define GSYNC() xcd_barrier(xbar, K_TID == 0)
#endif
__device__ __forceinline__ int lane_fresh() { unsigned m = ~0u; asm volatile("" : "+s"(m)); int t = (int)__builtin_amdgcn_mbcnt_hi(m, __builtin_amdgcn_mbcnt_lo(m, 0u)); asm volatile("" : "+v"(t)); return t; }
typedef const __attribute__((address_space(4))) Args* kargs_t;
__device__ __forceinline__ kargs_t kargs() { kargs_t p = (kargs_t)__builtin_amdgcn_kernarg_segment_ptr(); asm volatile("" : "+s"(p)); return p; }
#define AIN(i) (kargs()->in[i])
#define AOUT (kargs()->out)
#define AWS (kargs()->ws)
#define P_HN ((bf16_t*)(AWS + WS_HN))
#define P_Zb ((bf16_t*)(AWS + WS_Z))
#define P_LOGF ((float*)(AWS + WS_LOGF))
#define P_F2 ((float*)(AWS + WS_F2))
#define P_EDGE ((float*)(AWS + WS_EDGE))
#define P_PB ((bf16_t*)(AWS + WS_PB))
#define P_HB ((bf16_t*)(AWS + WS_HB))
#define P_RSQ ((u64_t*)(AWS + WS_RSQ))

__global__ void __launch_bounds__(512, 2) fwd_megakernel(Args a) {
    __shared__ __attribute__((aligned(16))) unsigned char lds_raw[LDS_TOTAL];
    cg::grid_group grid = cg::this_grid();
    LAS unsigned char* lds = (LAS unsigned char*)lds_raw;
    const int G = gridDim.x, bx = blockIdx.x, NGW = G * 8;
    const int wave_s = __builtin_amdgcn_readfirstlane((int)threadIdx.x >> 6);
#define K_TID ((wave_s << 6) | lane_fresh())
#define K_LANE (lane_fresh())
#define K_WAVE (wave_s)
#define K_GW (bx * 8 + K_WAVE)
    volatile LAS unsigned* xst = (volatile LAS unsigned*)(lds + LDS_XCH + 8192);
    if (K_TID < 4) xst[K_TID] = 0u;
    __syncthreads();
    XcdBarrier xbar = xcd_barrier_post((unsigned*)(AWS + WS_CTL), xst);
#ifdef PROBE_P0X2
    for (int rep_ = 0; rep_ < 2; ++rep_)
#endif
    {
        LAS float* scr = (LAS float*)(lds + K_WAVE * 8448);
        constexpr int I_IN = 16 * 112, I_OUT = 16 * 32, I_UP = 16 * 176, I_DN = 44 * 32, I_GT = 16 * 32, I_PJ = 4 * 32, I_L = I_IN + I_OUT + I_UP + I_DN + I_GT + I_PJ;
        for (int it = K_GW; it < 2 * I_L; it += NGW) {
            const int l = it / I_L; int r = it % I_L;
            if (r < I_IN) { transpose_item<1>(AIN(3) + (size_t)l * DM * INC, DM, INC, ZP, (bf16_t*)(AWS + WS_WIN + l * SZ_WIN), scr, r, K_LANE); continue; } r -= I_IN;
            if (r < I_OUT) { transpose_item<0>(AIN(9) + (size_t)l * DM * DM, DM, DM, DM, (bf16_t*)(AWS + WS_WOUT + l * SZ_WOUT), scr, r, K_LANE); continue; } r -= I_OUT;
            if (r < I_UP) { transpose_item<2>(AIN(11) + (size_t)l * DM * UPN, DM, UPN, UPN, (bf16_t*)(AWS + WS_WUP + l * SZ_WUP), scr, r, K_LANE, AIN(10) + l * DM); continue; } r -= I_UP;
            if (r < I_DN) { transpose_item<0>(AIN(14) + (size_t)l * DFF * DM, DFF, DM, DM, (bf16_t*)(AWS + WS_WDN + l * SZ_WDN), scr, r, K_LANE); continue; } r -= I_DN;
            if (r < I_GT) { transpose_item<0>(AIN(16) + (size_t)l * DM * DM, DM, DM, DM, (bf16_t*)(AWS + WS_WGT + l * SZ_WGT), scr, r, K_LANE, AIN(15) + l * DM); continue; } r -= I_GT;
            transpose_item<0>(AIN(17) + (size_t)l * PLED * DM, PLED, DM, DM, (bf16_t*)(AWS + WS_WPJ + l * SZ_WPJ), scr, r, K_LANE);
        }
        { unsigned* rq = (unsigned*)P_RSQ; for (int i = bx * 512 + K_TID; i < 8 * T; i += G * 512) rq[i] = 0u; }
        const size_t n8 = (size_t)2 * T * PLED / 8; const float* pp_ = AIN(1); bf16_t* pb_ = P_PB;
        for (size_t i = (size_t)bx * 512 + K_TID; i < n8; i += (size_t)G * 512) {
            const f32x4 v0 = *(const f32x4*)(pp_ + 8 * i), v1 = *(const f32x4*)(pp_ + 8 * i + 4);
            u32x4 w; w.x = pk2(v0[0], v0[1]); w.y = pk2(v0[2], v0[3]); w.z = pk2(v1[0], v1[1]); w.w = pk2(v1[2], v1[3]);
            *(u32x4*)(pb_ + 8 * i) = w;
        }
    }

    auto layer = [&](const int l) __attribute__((always_inline)) {

        {
#ifndef SKIP_NORMFG
            int lane_l = K_LANE, gw_l = K_GW; asm volatile("" : "+v"(lane_l), "+s"(gw_l));
#ifdef PROBE_P0X2
            for (int rep_ = 0; rep_ < 2; ++rep_)
#endif
            if (l == 0) norm_phase<true, false>(AIN(0), AIN(2) + l * DM, P_HN, AIN(3) + (size_t)l * DM * INC, AIN(7) + l * 6, P_LOGF, gw_l, NGW, lane_l);
            else norm_phase<true, true>((const float*)P_HB, AIN(2) + l * DM, P_HN, AIN(3) + (size_t)l * DM * INC, AIN(7) + l * 6, P_LOGF, gw_l, NGW, lane_l);
#endif
            if (l == 0 && gridDim.x > 1000000u) grid.sync();
            GSYNC();
        }
        {
#ifndef SKIP_SCAN
            if (bx < 48) { int tid_l = K_TID, bh_l = bx; asm volatile("" : "+v"(tid_l), "+s"(bh_l)); scan_unit(P_LOGF, P_F2, bh_l, (LAS double*)lds, tid_l); }
#endif
#ifndef SKIP_QKV
            pg8::Gemm g{P_HN, (const bf16_t*)(AWS + WS_WIN + l * SZ_WIN), T, ZP, DM}; pg8::StaticOrder S; S.init(T, ZP, G, bx);
            pg8::EpiQKV E{P_Zb, AIN(4) + l * 6 * 64};
#ifdef PROBE_PLAINQKV
            { pg8::EpiPlain EP{P_Zb}; pg8::gemm_phase<pg8::EpiPlain, pg8::StaticOrder, true, true>(lds, g, S, EP, K_TID); }
#endif
            pg8::gemm_phase<pg8::EpiQKV, pg8::StaticOrder, true, true>(lds, g, S, E, K_TID);
#ifdef PROBE_QKV2
            pg8::gemm_phase<pg8::EpiQKV, pg8::StaticOrder, true, true>(lds, g, S, E, K_TID);
#endif
#endif
        }
        GSYNC();
        {
            int lane_l = K_LANE, tid_l = K_TID; asm volatile("" : "+v"(lane_l), "+v"(tid_l));
            const float* gq = AIN(4) + l * 6 * 64;
            float mg[6];
#pragma unroll
            for (int j = 0; j < 6; ++j) mg[j] = wave_max(fabsf(gq[j * 64 + lane_l]));
            const float* rel = AIN(8) + l * 6 * 257;
            float mr = 0.f;
            for (int i = lane_l; i < 6 * 257; i += 64) mr = fmaxf(mr, fabsf(rel[i]));
            mr = wave_max(mr);
            const float* lp = AIN(5) + l * 4 * 64;
            const float s01 = wave_sum(lp[lane_l] * lp[64 + lane_l]), s23 = wave_sum(lp[128 + lane_l] * lp[192 + lane_l]);
            const float lam_init = (l == 0) ? 0.2f : (0.8f - 0.6f * 0.7408182206817179f);
            AttnCtx C;
            C.Z = P_Zb; C.O = P_HN; C.F2 = P_F2; C.rel = rel; C.subln = AIN(6) + l * 64;
            C.lam = expf(s01) - expf(s23) + lam_init; C.oml = 1.0f - lam_init;
            C.Mb0 = 8.0f * mg[0] * mg[1] * LOG2E * 1.02f + 1.0f; C.Mb1 = 8.0f * mg[2] * mg[3] * LOG2E * 1.02f + 1.0f; C.Mb2 = 8.0f * mg[4] * mg[5] * LOG2E * 1.02f + 1.0f + mr * LOG2E;
#ifndef SKIP_ATTN
            #define RFL(x) __uint_as_float(__builtin_amdgcn_readfirstlane(__float_as_uint(x)))
            C.lam = RFL(C.lam); C.oml = RFL(C.oml); C.Mb0 = RFL(C.Mb0); C.Mb1 = RFL(C.Mb1); C.Mb2 = RFL(C.Mb2);
            attn_phase(C, (unsigned*)(AWS + WS_CTL) + CTL_Q + 16 * (1 + l), lds, tid_l);
#ifdef PROBE_ATTN2
            attn_phase(C, (unsigned*)(AWS + WS_CTL) + CTL_Q + 16 * (1 + l) + 8, lds, tid_l);
#endif
#endif
        }
        GSYNC();
        {
            pg8::Gemm g{P_HN, (const bf16_t*)(AWS + WS_WOUT + l * SZ_WOUT), T, DM, DM}; pg8::StaticOrder S; S.init(T, DM, G, bx);
            pg8::EpiResid E{(l == 0) ? AIN(0) : (const float*)nullptr, P_HB, P_RSQ + (size_t)(2 * l) * T};
            pg8::gemm_phase<pg8::EpiResid, pg8::StaticOrder, true, true>(lds, g, S, E, K_TID);
        }
        GSYNC();
        {
            pg8::Gemm g{P_HB, (const bf16_t*)(AWS + WS_WUP + l * SZ_WUP), T, UPN, DM}; pg8::StaticOrder S; S.init(T, UPN, G, bx);
            pg8::EpiUp E{P_Zb, AIN(12) + (size_t)l * 3 * UPN, AIN(13) + l * UPN, P_EDGE, (LAS float*)(lds + LDS_XCH), P_RSQ + (size_t)(2 * l) * T, (LAS float*)(lds + LDS_PRM), (LAS float*)(lds + LDS_RSD)};
#ifndef SKIP_UP
            pg8::gemm_phase<pg8::EpiUp, pg8::StaticOrder, true, true>(lds, g, S, E, K_TID);
#ifdef PROBE_UP2
            pg8::gemm_phase<pg8::EpiUp, pg8::StaticOrder, true, true>(lds, g, S, E, K_TID);
#endif
#endif
        }
        GSYNC();
        {
            pg8::Gemm g{P_Zb, (const bf16_t*)(AWS + WS_WDN + l * SZ_WDN), T, DM, DFF}; pg8::StaticOrder S; S.init(T, DM, G, bx);
            pg8::Unit u;
            int tid_l = K_TID; asm volatile("" : "+v"(tid_l));
            for (int i = 0; S.next(i, u); ++i) fix_rows(P_Zb, P_EDGE, AIN(12) + (size_t)l * 3 * UPN, AIN(13) + l * UPN, u.pm, tid_l);
            __threadfence();
            __syncthreads();
            pg8::EpiResid E{nullptr, P_HB, P_RSQ + (size_t)(2 * l + 1) * T};
            pg8::gemm_phase<pg8::EpiResid, pg8::StaticOrder, true, true>(lds, g, S, E, K_TID);
        }
        GSYNC();
        {
            bf16_t* SG = P_Zb;
            pg8::StaticOrder S; S.init(T, DM, G, bx);
            { pg8::Gemm g{P_HB, (const bf16_t*)(AWS + WS_WGT + l * SZ_WGT), T, DM, DM}; pg8::EpiSig E{SG, P_RSQ + (size_t)(2 * l + 1) * T};
              pg8::gemm_phase<pg8::EpiSig, pg8::StaticOrder, true, true>(lds, g, S, E, K_TID);
#ifdef PROBE_SIG2
              pg8::gemm_phase<pg8::EpiSig, pg8::StaticOrder, true, true>(lds, g, S, E, K_TID);
#endif
            }
            GSYNC();
            { int kple = PLED; asm volatile("" : "+s"(kple));
              pg8::Gemm g{P_PB + (size_t)l * T * PLED, (const bf16_t*)(AWS + WS_WPJ + l * SZ_WPJ), T, DM, kple}; pg8::EpiMulAdd E{SG, P_HB, (l == 1) ? AOUT : (float*)nullptr};
              pg8::gemm_phase<pg8::EpiMulAdd, pg8::StaticOrder, true, true>(lds, g, S, E, K_TID); }
        }
        if (l == 0) GSYNC();
    };
    layer(0);
    layer(1);
}

extern "C" void kernel_launch(void* const* d_in, const int* in_sizes, int n_in, void* d_out, int out_size, void* d_ws, size_t ws_size, hipStream_t stream) {
    static int grid_blocks = 0;
    if (!grid_blocks) {
        int dev = 0, cus = 0, per_cu = 0;
        hipGetDevice(&dev);
        hipDeviceGetAttribute(&cus, hipDeviceAttributeMultiprocessorCount, dev);
        hipOccupancyMaxActiveBlocksPerMultiprocessor(&per_cu, fwd_megakernel, 512, 0);
        if (per_cu < 1) per_cu = 1;
        if (cus < 1) cus = 256;
        grid_blocks = cus * 1;
        if (n_in != 18 || ws_size < WS_END) fprintf(stderr, "kernel_launch: unexpected n_in %d or ws_size %zu (< %zu)\n", n_in, ws_size, (size_t)WS_END);
    }
    hipMemsetAsync(d_ws, 0, 16384, stream);
    Args a{};
    for (int i = 0; i < 18; ++i) a.in[i] = (const float*)d_in[i];
    a.out = (float*)d_out; a.ws = (unsigned char*)d_ws;
    void* args[] = {&a};
    hipError_t e = hipLaunchCooperativeKernel((void*)fwd_megakernel, dim3(grid_blocks), dim3(512), args, 0, stream);
    if (e != hipSuccess) fprintf(stderr, "cooperative launch failed: %s (grid %d)\n", hipGetErrorString(e), grid_blocks);
}
```

```cpp
#include <hip/hip_runtime.h>
#include <hip/hip_cooperative_groups.h>
#include <cstdio>
#include <cstdint>
namespace cg = cooperative_groups;

#define LAS __attribute__((address_space(3)))
typedef unsigned short bf16_t;
typedef short bf16x8 __attribute__((ext_vector_type(8)));
typedef short s16x4 __attribute__((ext_vector_type(4)));
typedef float f32x4 __attribute__((ext_vector_type(4)));
typedef float f32x16 __attribute__((ext_vector_type(16)));
typedef unsigned u32x4 __attribute__((ext_vector_type(4)));
typedef unsigned u32x2 __attribute__((ext_vector_type(2)));
typedef float f32x2_t __attribute__((ext_vector_type(2)));
typedef __bf16 bf16x2_t __attribute__((ext_vector_type(2)));

constexpr int NB = 8, SEQ = 4096, T = NB * SEQ, DM = 1024, ZP = 3584, DFF = 2816, UPN = 5632, PLED = 256, INC = 3590;
constexpr float EPS = 1e-6f, LOG2E = 1.4426950408889634f, C2 = 0.125f * 1.4426950408889634f;

constexpr size_t WS_CTL = 0;
constexpr size_t SZ_WIN = (size_t)ZP * DM * 2, SZ_WOUT = (size_t)DM * DM * 2, SZ_WUP = (size_t)UPN * DM * 2, SZ_WDN = (size_t)DM * DFF * 2, SZ_WGT = (size_t)DM * DM * 2, SZ_WPJ = (size_t)DM * PLED * 2;
constexpr size_t SZ_PB = (size_t)T * PLED * 2, SZ_HN = (size_t)T * DM * 2, SZ_Z = (size_t)T * ZP * 2, SZ_LOGF = (size_t)T * 6 * 4, SZ_EDGE = (size_t)128 * 22 * 1024 * 4;
constexpr size_t WS_WIN = 16384;
constexpr int CTL_Q = 3584;
constexpr size_t WS_WOUT = WS_WIN + 2 * SZ_WIN;
constexpr size_t WS_WUP = WS_WOUT + 2 * SZ_WOUT;
constexpr size_t WS_WDN = WS_WUP + 2 * SZ_WUP;
constexpr size_t WS_WGT = WS_WDN + 2 * SZ_WDN;
constexpr size_t WS_WPJ = WS_WGT + 2 * SZ_WGT;
constexpr size_t WS_PB = WS_WPJ + 2 * SZ_WPJ;
constexpr size_t WS_HN = WS_PB + 2 * SZ_PB;
constexpr size_t WS_Z = WS_HN + SZ_HN;
constexpr size_t WS_LOGF = WS_Z + SZ_Z;
constexpr size_t WS_F2 = WS_LOGF + SZ_LOGF;
constexpr size_t WS_EDGE = WS_F2 + SZ_LOGF;
constexpr size_t WS_HB = WS_EDGE + SZ_EDGE;
constexpr size_t WS_RSQ = WS_HB + SZ_HN;
constexpr size_t SZ_RSQ = (size_t)4 * T * 8;
constexpr size_t WS_END = WS_RSQ + SZ_RSQ;

__device__ __forceinline__ unsigned pk2(float lo, float hi) { f32x2_t v = {lo, hi}; bf16x2_t b = __builtin_convertvector(v, bf16x2_t); return __builtin_bit_cast(unsigned, b); }
#define DPPF(v, ctrl) __builtin_bit_cast(float, __builtin_amdgcn_update_dpp(0, __builtin_bit_cast(int, (v)), (ctrl), 0xf, 0xf, false))
__device__ __forceinline__ float xor16_sum(float v) { const auto r = __builtin_amdgcn_permlane16_swap(__float_as_uint(v), __float_as_uint(v), false, false); return __uint_as_float(r[0]) + __uint_as_float(r[1]); }
__device__ __forceinline__ float xor32_sum(float v) { const auto r = __builtin_amdgcn_permlane32_swap(__float_as_uint(v), __float_as_uint(v), false, false); return __uint_as_float(r[0]) + __uint_as_float(r[1]); }
__device__ __forceinline__ float xor16_max(float v) { const auto r = __builtin_amdgcn_permlane16_swap(__float_as_uint(v), __float_as_uint(v), false, false); return fmaxf(__uint_as_float(r[0]), __uint_as_float(r[1])); }
__device__ __forceinline__ float xor32_max(float v) { const auto r = __builtin_amdgcn_permlane32_swap(__float_as_uint(v), __float_as_uint(v), false, false); return fmaxf(__uint_as_float(r[0]), __uint_as_float(r[1])); }
__device__ __forceinline__ float row16_sum(float v) { v += DPPF(v, 0xB1); v += DPPF(v, 0x4E); v += DPPF(v, 0x141); v += DPPF(v, 0x140); return v; }
__device__ __forceinline__ float wave_sum(float v) { return xor32_sum(xor16_sum(row16_sum(v))); }
__device__ __forceinline__ float wave_max(float v) {
    v = fmaxf(v, DPPF(v, 0xB1)); v = fmaxf(v, DPPF(v, 0x4E)); v = fmaxf(v, DPPF(v, 0x141)); v = fmaxf(v, DPPF(v, 0x140));
    return xor32_max(xor16_max(v));
}
__device__ __forceinline__ float fast_exp2(float x) { return __builtin_amdgcn_exp2f(x); }
__device__ __forceinline__ float fast_rcp(float x) { return __builtin_amdgcn_rcpf(x); }
__device__ __forceinline__ float fast_rsq(float x) { return __builtin_amdgcn_rsqf(x); }
typedef unsigned long long u64_t;
__device__ __forceinline__ float rsq_sum(const u64_t* rsq, int row) { return (float)rsq[row] * (1.0f / 16777216.0f); }
__device__ __forceinline__ float row_rstd(const u64_t* rsq, int row) { return fast_rsq(rsq_sum(rsq, row) * (1.0f / DM) + EPS); }
__device__ __forceinline__ float sigmoidf_(float v) { return fast_rcp(1.0f + fast_exp2(-v * LOG2E)); }
#define XB_TMO      128
#define XB_XCNT(j)  (256  + 64 * (j))
#define XB_XSUB(j)  (1280 + 64 * (j))
#define XB_XGEN(j)  (2304 + 64 * (j))
#define XB_TOP      3328
#define XB_TOPGEN   3392
#define XCD_BAR_WORDS 3456
#define XB_SPIN_CAP (1u << 18)
__device__ __forceinline__ unsigned xb_ld(unsigned* p)              { return __hip_atomic_load(p, __ATOMIC_RELAXED, __HIP_MEMORY_SCOPE_AGENT); }
__device__ __forceinline__ unsigned xb_add(unsigned* p, unsigned v) { return __hip_atomic_fetch_add(p, v, __ATOMIC_RELAXED, __HIP_MEMORY_SCOPE_AGENT); }
__device__ __forceinline__ unsigned xb_xcc_id() { return (unsigned)__builtin_amdgcn_s_getreg((3 << 11) | 20) & 0xFu; }
#define XB_SPIN(cond, bar) do { unsigned _sp = 0; while (cond) { __builtin_amdgcn_s_sleep(1); \
    if ((++_sp & 255u) == 0u) { if (xb_ld(&(bar)[XB_TMO])) break; if (_sp > XB_SPIN_CAP) { atomicAdd(&(bar)[XB_TMO], 1u); break; } } } } while (0)

struct XcdBarrier {
    unsigned* bar; unsigned x;
    volatile LAS unsigned* st;
};

__device__ __forceinline__ XcdBarrier xcd_barrier_post(unsigned* bar, volatile LAS unsigned* st) {
    XcdBarrier b; b.bar = bar; b.x = xb_xcc_id(); b.st = st;
    if (threadIdx.x == 0) (void)xb_add(&bar[XB_XCNT(b.x)], 1u);
    return b;
}
__device__ __forceinline__ void xcd_barrier_complete(unsigned* bar, unsigned x, unsigned& nloc, unsigned& nx) {
    const unsigned G = gridDim.x * gridDim.y * gridDim.z;
    unsigned sum, cnt, mine, sp = 0u;
    for (;;) {
        sum = 0u; cnt = 0u; mine = 0u;
#pragma unroll
        for (unsigned j = 0; j < 16; ++j) { const unsigned c = xb_ld(&bar[XB_XCNT(j)]); sum += c; cnt += (c > 0u) ? 1u : 0u; mine = (j == x) ? c : mine; }
        if (sum == G) break;
        __builtin_amdgcn_s_sleep(1);
        if ((++sp & 255u) == 0u) { if (xb_ld(&bar[XB_TMO])) break; if (sp > XB_SPIN_CAP) { atomicAdd(&bar[XB_TMO], 1u); break; } }
    }
    nloc = mine > 0u ? mine : 1u; nx = cnt > 0u ? cnt : 1u;
}

__device__ __forceinline__ void xcd_barrier(const XcdBarrier& b, const bool xb_is_leader) {
    asm volatile("s_waitcnt vmcnt(0)" ::: "memory");
    __syncthreads();
    if (xb_is_leader) {
        unsigned* bar = b.bar;
        __builtin_amdgcn_s_waitcnt(0);
        unsigned nloc = b.st[0], nx = b.st[1];
        if (nloc == 0u) { xcd_barrier_complete(bar, b.x, nloc, nx); b.st[0] = nloc; b.st[1] = nx; }
        const unsigned old = xb_add(&bar[XB_XSUB(b.x)], 1u);
        const unsigned gen = old / nloc;
        if (old + 1u == (gen + 1u) * nloc) {
            __builtin_amdgcn_fence(__ATOMIC_RELEASE, "agent");
            asm volatile("s_waitcnt vmcnt(0)" ::: "memory");
            const unsigned og = xb_add(&bar[XB_TOP], 1u);
            const unsigned tg = og / nx;
            if (og + 1u == (tg + 1u) * nx) xb_add(&bar[XB_TOPGEN], 1u);
            else XB_SPIN(xb_ld(&bar[XB_TOPGEN]) == tg, bar);
            __builtin_amdgcn_fence(__ATOMIC_ACQUIRE, "agent");
            xb_add(&bar[XB_XGEN(b.x)], 1u);
            asm volatile("s_waitcnt vmcnt(0)" ::: "memory");
        } else {
            XB_SPIN(xb_ld(&bar[XB_XGEN(b.x)]) == gen, bar);
            __builtin_amdgcn_fence(__ATOMIC_ACQUIRE, "agent");
            asm volatile("s_waitcnt vmcnt(0)" ::: "memory");
        }
    }
    __syncthreads();
}
namespace pg8 {
#define PG8_LAS __attribute__((address_space(3)))
typedef unsigned short bf16_t;
typedef short bf16x8 __attribute__((ext_vector_type(8)));
typedef float f32x4 __attribute__((ext_vector_type(4)));
typedef unsigned u32x4 __attribute__((ext_vector_type(4)));
constexpr int BM = 256, BK = 64, HALF = 128, HTB = HALF * BK * 2  , STAGE_BYTES = 8 * HTB, NXCD = 8, WGM = 8;

__host__ __device__ __forceinline__ int lds_byte(int r, int c) { const int st = (r >> 4) * 2 + (c >> 5), rr = r & 15, cc = c & 31, ob = rr * 64 + cc * 2; return st * 1024 + (ob ^ (((ob >> 9) & 1) << 5)); }
__host__ __device__ __forceinline__ void stage_rc(int b, int& R, int& C) { const int st = b / 1024, sb = b % 1024, swz = sb ^ (((sb >> 9) & 1) << 5); R = (st >> 1) * 16 + swz / 64; C = (st & 1) * 32 + (swz % 64) / 2; }
__host__ __device__ __forceinline__ int perm32(int rho) { const int n = rho >> 4, i = rho & 15; return 8 * (i >> 2) + 4 * n + (i & 3); }

struct Unit { int pm, pn; };
struct Gemm { const bf16_t* A; const bf16_t* Bt; int M, N, K; };

struct StaticOrder {
    int nM, nN, nwg, G, c;
    __host__ __device__ void init(int M, int N, int G_, int c_) { nM = M / BM; nN = N / BM; nwg = nM * nN; G = G_; c = c_; }
    __host__ __device__ bool next(int i, Unit& u) const {
        const long L = (long)i * G + c; if (L >= nwg) return false;
        int wgid = (int)L; { const int q = nwg / NXCD, r = nwg % NXCD, xcd = wgid % NXCD, off = wgid / NXCD; wgid = (xcd < r ? xcd * (q + 1) : r * (q + 1) + (xcd - r) * q) + off; }
        const int nig = WGM * nN, gid = wgid / nig, fm = gid * WGM, gsz = (nM - fm) < WGM ? (nM - fm) : WGM;
        u.pm = fm + ((wgid % nig) % gsz); u.pn = (wgid % nig) / gsz; return true;
    }
    __device__ __forceinline__ void a_ready(const Unit&) const {}
    __device__ __forceinline__ void done(const Unit&) const {}
};

#define BPERM(v, srclane) __builtin_bit_cast(float, __builtin_amdgcn_ds_bpermute((srclane) << 2, __builtin_bit_cast(int, (float)(v))))
#define PG8_EPI_BAR() do { asm volatile("s_waitcnt lgkmcnt(0)" ::: "memory"); __builtin_amdgcn_s_barrier(); asm volatile("" ::: "memory"); } while (0)

struct EpiQKV {
    static constexpr bool PERM = true, AFTER_DRAIN = false, WANTS_NEXT = false, PERMA = false;
    bf16_t* Z; const float* gain;
    __device__ __forceinline__ void operator()(const f32x4 (&acc)[2][2][4][2], const Unit& u, int wr, int wc, int fr_in, int fq_in) const {
        int fr = fr_in, fq = fq_in; asm volatile("" : "+v"(fr), "+v"(fq));
        const int G = 4 * u.pn + wc;
        int gi; float sc = 1.f;
        if (G < 8) { gi = 0; sc = C2; } else if (G < 16) gi = 1; else if (G < 20) gi = -1; else if (G < 26) { gi = 2; sc = C2; } else if (G < 32) gi = 3;
        else if (G < 38) gi = -1; else if (G < 44) { gi = 4; sc = C2; } else if (G < 50) gi = 5; else gi = -1;
        f32x4 g[2][2];
#pragma unroll
        for (int bj = 0; bj < 2; ++bj) { g[bj][0] = (f32x4){1.f, 1.f, 1.f, 1.f}; g[bj][1] = g[bj][0]; }
        if (gi >= 0) {
#pragma unroll
            for (int bj = 0; bj < 2; ++bj) { const float* gp = gain + gi * 64 + 32 * bj + 8 * fq; g[bj][0] = *(const f32x4*)gp * sc; g[bj][1] = *(const f32x4*)(gp + 4) * sc; }
        }
        bf16_t* zb = Z + (size_t)(u.pm * BM + wr * 64 + fr) * ZP + u.pn * BM + wc * 64 + 8 * fq;
#pragma unroll
        for (int ai = 0; ai < 2; ++ai)
#pragma unroll
            for (int m = 0; m < 4; ++m) {
                float rstd = 1.f;
                if (gi >= 0) {
                    float s = 0.f;
#pragma unroll
                    for (int bj = 0; bj < 2; ++bj) { const f32x4 x0 = acc[ai][bj][m][0], x1 = acc[ai][bj][m][1];
                        s += (x0[0] * x0[0] + x0[1] * x0[1]) + (x0[2] * x0[2] + x0[3] * x0[3]) + (x1[0] * x1[0] + x1[1] * x1[1]) + (x1[2] * x1[2] + x1[3] * x1[3]); }
                    s = xor32_sum(xor16_sum(s));
                    rstd = fast_rsq(s * (1.0f / 64.0f) + EPS);
                }
#pragma unroll
                for (int bj = 0; bj < 2; ++bj) {
                    const f32x4 v0 = acc[ai][bj][m][0] * g[bj][0] * rstd, v1 = acc[ai][bj][m][1] * g[bj][1] * rstd;
                    u32x4 w; w.x = pk2(v0[0], v0[1]); w.y = pk2(v0[2], v0[3]); w.z = pk2(v1[0], v1[1]); w.w = pk2(v1[2], v1[3]);
                    *(u32x4*)(zb + (size_t)(ai * 128 + m * 16) * ZP + 32 * bj) = w;
                }
            }
    }
};

struct EpiPlain {
    static constexpr bool PERM = true, AFTER_DRAIN = false, WANTS_NEXT = false, PERMA = false;
    bf16_t* Z;
    __device__ __forceinline__ void operator()(const f32x4 (&acc)[2][2][4][2], const Unit& u, int wr, int wc, int fr_in, int fq_in) const {
        int fr = fr_in, fq = fq_in; asm volatile("" : "+v"(fr), "+v"(fq));
#pragma unroll
        for (int ai = 0; ai < 2; ++ai)
#pragma unroll
            for (int m = 0; m < 4; ++m)
#pragma unroll
                for (int bj = 0; bj < 2; ++bj) {
                    const f32x4 v0 = acc[ai][bj][m][0], v1 = acc[ai][bj][m][1];
                    u32x4 w; w.x = pk2(v0[0], v0[1]); w.y = pk2(v0[2], v0[3]); w.z = pk2(v1[0], v1[1]); w.w = pk2(v1[2], v1[3]);
                    *(u32x4*)(Z + (size_t)(u.pm * BM + ai * 128 + wr * 64 + m * 16 + fr) * ZP + u.pn * BM + bj * HALF + wc * 32 + 8 * fq) = w;
                }
    }
};

#define BF16_LO(w) __uint_as_float((w) << 16)
#define BF16_HI(w) __uint_as_float((w) & 0xffff0000u)
struct EpiResid {
    static constexpr bool PERM = true, AFTER_DRAIN = false, WANTS_NEXT = false, PERMA = false;
    const float* xbase; bf16_t* hb; u64_t* rsq;
    __device__ __forceinline__ void operator()(const f32x4 (&acc)[2][2][4][2], const Unit& u, int wr, int wc, int fr_in, int fq_in) const {
        int fr = fr_in, fq = fq_in; asm volatile("" : "+v"(fr), "+v"(fq));
#pragma unroll
        for (int ai = 0; ai < 2; ++ai)
#pragma unroll
            for (int m = 0; m < 4; ++m) {
                const int row = u.pm * BM + ai * 128 + wr * 64 + m * 16 + fr;
                float s = 0.f;
#pragma unroll
                for (int bj = 0; bj < 2; ++bj) {
                    const size_t off = (size_t)row * DM + u.pn * BM + bj * HALF + wc * 32 + 8 * fq;
                    f32x4 b0, b1;
                    if (xbase) { b0 = *(const f32x4*)(xbase + off); b1 = *(const f32x4*)(xbase + off + 4); }
                    else { const u32x4 q = *(const u32x4*)(hb + off);
                        b0 = (f32x4){BF16_LO(q.x), BF16_HI(q.x), BF16_LO(q.y), BF16_HI(q.y)}; b1 = (f32x4){BF16_LO(q.z), BF16_HI(q.z), BF16_LO(q.w), BF16_HI(q.w)}; }
                    const f32x4 h0 = b0 + acc[ai][bj][m][0], h1 = b1 + acc[ai][bj][m][1];
                    u32x4 w; w.x = pk2(h0[0], h0[1]); w.y = pk2(h0[2], h0[3]); w.z = pk2(h1[0], h1[1]); w.w = pk2(h1[2], h1[3]);
                    *(u32x4*)(hb + off) = w;
                    s += (h0[0] * h0[0] + h0[1] * h0[1]) + (h0[2] * h0[2] + h0[3] * h0[3]) + (h1[0] * h1[0] + h1[1] * h1[1]) + (h1[2] * h1[2] + h1[3] * h1[3]);
                }
                s = xor32_sum(xor16_sum(s));
                if (fq == 0) atomicAdd(rsq + row, (u64_t)(s * 16777216.0f));
                if (m == 3) asm volatile("" ::: "memory");
            }
    }
};

struct EpiSig {
    static constexpr bool PERM = true, AFTER_DRAIN = false, WANTS_NEXT = false, PERMA = false;
    bf16_t* SG; const u64_t* rsq;
    __device__ __forceinline__ void operator()(const f32x4 (&acc)[2][2][4][2], const Unit& u, int wr, int wc, int fr_in, int fq_in) const {
        int fr = fr_in, fq = fq_in; asm volatile("" : "+v"(fr), "+v"(fq));
        const int rowb = u.pm * BM + wr * 64 + fr;
        float rs[2][4];
#pragma unroll
        for (int ai = 0; ai < 2; ++ai)
#pragma unroll
            for (int m = 0; m < 4; ++m) rs[ai][m] = rsq_sum(rsq, rowb + ai * 128 + m * 16);
#pragma unroll
        for (int ai = 0; ai < 2; ++ai)
#pragma unroll
            for (int m = 0; m < 4; ++m) rs[ai][m] = fast_rsq(rs[ai][m] * (1.0f / DM) + EPS);
#pragma unroll
        for (int ai = 0; ai < 2; ++ai)
#pragma unroll
            for (int m = 0; m < 4; ++m) {
                const int row = rowb + ai * 128 + m * 16;
#pragma unroll
                for (int bj = 0; bj < 2; ++bj) {
                    const size_t off = (size_t)row * DM + u.pn * BM + bj * HALF + wc * 32 + 8 * fq;
                    const f32x4 a = acc[ai][bj][m][0] * rs[ai][m], b = acc[ai][bj][m][1] * rs[ai][m];
                    u32x4 w; w.x = pk2(sigmoidf_(a[0]), sigmoidf_(a[1])); w.y = pk2(sigmoidf_(a[2]), sigmoidf_(a[3]));
                    w.z = pk2(sigmoidf_(b[0]), sigmoidf_(b[1])); w.w = pk2(sigmoidf_(b[2]), sigmoidf_(b[3]));
                    *(u32x4*)(SG + off) = w;
                }
            }
    }
};

struct EpiMulAdd {
    static constexpr bool PERM = true, AFTER_DRAIN = false, WANTS_NEXT = false, PERMA = false;
    const bf16_t* SG; bf16_t* hb; float* outf;
    __device__ __forceinline__ void operator()(const f32x4 (&acc)[2][2][4][2], const Unit& u, int wr, int wc, int fr_in, int fq_in) const {
        int fr = fr_in, fq = fq_in; asm volatile("" : "+v"(fr), "+v"(fq));
#pragma unroll
        for (int ai = 0; ai < 2; ++ai)
#pragma unroll
            for (int m = 0; m < 4; ++m)
#pragma unroll
                for (int bj = 0; bj < 2; ++bj) {
                    const size_t off = (size_t)(u.pm * BM + ai * 128 + wr * 64 + m * 16 + fr) * DM + u.pn * BM + bj * HALF + wc * 32 + 8 * fq;
                    const u32x4 s = *(const u32x4*)(SG + off), q = *(const u32x4*)(hb + off);
                    const f32x4 s0 = {BF16_LO(s.x), BF16_HI(s.x), BF16_LO(s.y), BF16_HI(s.y)}, s1 = {BF16_LO(s.z), BF16_HI(s.z), BF16_LO(s.w), BF16_HI(s.w)};
                    const f32x4 b0 = {BF16_LO(q.x), BF16_HI(q.x), BF16_LO(q.y), BF16_HI(q.y)}, b1 = {BF16_LO(q.z), BF16_HI(q.z), BF16_LO(q.w), BF16_HI(q.w)};
                    const f32x4 h0 = b0 + acc[ai][bj][m][0] * s0, h1 = b1 + acc[ai][bj][m][1] * s1;
                    if (outf) { *(f32x4*)(outf + off) = h0; *(f32x4*)(outf + off + 4) = h1; }
                    else { u32x4 w; w.x = pk2(h0[0], h0[1]); w.y = pk2(h0[2], h0[3]); w.z = pk2(h1[0], h1[1]); w.w = pk2(h1[2], h1[3]); *(u32x4*)(hb + off) = w; }
                    if (bj == 1 && (m & 1)) asm volatile("" ::: "memory");
                }
    }
};

struct EpiUp {
    static constexpr bool PERM = false, AFTER_DRAIN = false, WANTS_NEXT = true, PERMA = true;
    bf16_t* A; const float* cw; const float* cb; float* edge; PG8_LAS float* xr; const u64_t* rsq; PG8_LAS float* prm; PG8_LAS float* rsd;
    __device__ __forceinline__ float ldp(int j, int pn) const { const int gv = j >> 9, tap = (j >> 7) & 3, col = gv * DFF + 128 * pn + (j & 127); return tap < 3 ? cw[tap * UPN + col] : cb[col]; }
#define DPPO(oldv, v, ctrl) __builtin_bit_cast(float, __builtin_amdgcn_update_dpp(__builtin_bit_cast(int, (float)(oldv)), __builtin_bit_cast(int, (float)(v)), (ctrl), 0xf, 0xf, false))
    __device__ __forceinline__ void run(const f32x4 (&acc)[2][2][4][2], const Unit& u, const Unit& nxt, bool has_next, int ui, int wr, int wc, int fr_in, int fq_in) const {
        int fr = fr_in, fq = fq_in; asm volatile("" : "+v"(fr), "+v"(fq));
        const int tid = (wr * 4 + wc) * 64 + fq * 16 + fr;
        const int slot = ui & 1;
        if (ui == 0) {
            prm[slot * 1024 + tid] = ldp(tid, u.pn); prm[slot * 1024 + tid + 512] = ldp(tid + 512, u.pn);
            if (tid < 256) rsd[slot * 256 + tid] = row_rstd(rsq, u.pm * BM + tid);
            PG8_EPI_BAR();
        }
        float nx0 = 0.f, nx1 = 0.f, nrs = 1.f;
        if (has_next) { nx0 = ldp(tid, nxt.pn); nx1 = ldp(tid + 512, nxt.pn); if (tid < 256) nrs = rsq_sum(rsq, nxt.pm * BM + tid); }
        float* eg = edge + (size_t)(u.pm * 22 + u.pn) * 1024;
        float rs[2][4];
#pragma unroll
        for (int ai = 0; ai < 2; ++ai)
#pragma unroll
            for (int m = 0; m < 4; ++m) rs[ai][m] = rsd[slot * 256 + ai * 128 + wr * 64 + 4 * fr + m];
#pragma unroll
        for (int bj = 0; bj < 2; ++bj)
#pragma unroll
            for (int n = 0; n < 2; ++n) {
                const int colt = bj * 128 + wc * 32 + n * 16 + 4 * fq;
                if (fr == 15) {
                    *(PG8_LAS f32x4*)(xr + ((0 + wr) * 2 + 0) * 256 + colt) = acc[0][bj][2][n] * rs[0][2]; *(PG8_LAS f32x4*)(xr + ((0 + wr) * 2 + 1) * 256 + colt) = acc[0][bj][3][n] * rs[0][3];
                    *(PG8_LAS f32x4*)(xr + ((2 + wr) * 2 + 0) * 256 + colt) = acc[1][bj][2][n] * rs[1][2]; *(PG8_LAS f32x4*)(xr + ((2 + wr) * 2 + 1) * 256 + colt) = acc[1][bj][3][n] * rs[1][3];
                    if (wr == 1) { *(f32x4*)(eg + 2 * 256 + colt) = acc[1][bj][2][n] * rs[1][2]; *(f32x4*)(eg + 3 * 256 + colt) = acc[1][bj][3][n] * rs[1][3]; }
                }
                if (wr == 0 && fr == 0) { *(f32x4*)(eg + colt) = acc[0][bj][0][n] * rs[0][0]; *(f32x4*)(eg + 256 + colt) = acc[0][bj][1][n] * rs[0][1]; }
            }
        PG8_EPI_BAR();
#pragma unroll
        for (int ai = 0; ai < 2; ++ai)
#pragma unroll
            for (int m = 0; m < 4; ++m) asm volatile("" : "+v"(rs[ai][m]));
#pragma unroll
        for (int n = 0; n < 2; ++n) {
            const int cl = wc * 32 + n * 16 + 4 * fq, ch = u.pn * 128 + cl;
            const PG8_LAS float* pp = prm + slot * 1024 + cl;
            const f32x4 wg0 = *(const PG8_LAS f32x4*)(pp), wg1 = *(const PG8_LAS f32x4*)(pp + 128), wg2 = *(const PG8_LAS f32x4*)(pp + 256), bg = *(const PG8_LAS f32x4*)(pp + 384);
            const f32x4 wv0 = *(const PG8_LAS f32x4*)(pp + 512), wv1 = *(const PG8_LAS f32x4*)(pp + 640), wv2 = *(const PG8_LAS f32x4*)(pp + 768), bv = *(const PG8_LAS f32x4*)(pp + 896);
#pragma unroll
            for (int ai = 0; ai < 2; ++ai) {
                const int grp = 2 * ai + wr;
                f32x4 hg2 = {0.f, 0.f, 0.f, 0.f}, hg3 = hg2, hv2 = hg2, hv3 = hg2;
                if (grp > 0 && fr == 0) { const PG8_LAS float* xp = xr + ((grp - 1) * 2) * 256 + cl;
                    hg2 = *(const PG8_LAS f32x4*)(xp); hg3 = *(const PG8_LAS f32x4*)(xp + 256); hv2 = *(const PG8_LAS f32x4*)(xp + 128); hv3 = *(const PG8_LAS f32x4*)(xp + 256 + 128); }
                f32x4 pg2, pg1, pv2, pv1;
                {
                    const f32x4 g2 = acc[ai][0][2][n] * rs[ai][2], g3 = acc[ai][0][3][n] * rs[ai][3], v2 = acc[ai][1][2][n] * rs[ai][2], v3 = acc[ai][1][3][n] * rs[ai][3];
#pragma unroll
                    for (int i = 0; i < 4; ++i) {
                        float a0 = g2[i], a1 = g3[i], a2 = v2[i], a3 = v3[i];
                        asm volatile("" : "+v"(a0), "+v"(a1), "+v"(a2), "+v"(a3));
                        const float t0 = DPPF(a0, 0x111), t1 = DPPF(a1, 0x111), t2 = DPPF(a2, 0x111), t3 = DPPF(a3, 0x111);
                        pg2[i] = t0 + hg2[i]; pg1[i] = t1 + hg3[i]; pv2[i] = t2 + hv2[i]; pv1[i] = t3 + hv3[i]; }
                }
#pragma unroll
                for (int m = 0; m < 4; ++m) {
                    const f32x4 gc = acc[ai][0][m][n] * rs[ai][m], vc = acc[ai][1][m][n] * rs[ai][m];
                    const f32x4 cgt = bg + wg0 * pg2 + wg1 * pg1 + wg2 * gc, cvl = bv + wv0 * pv2 + wv1 * pv1 + wv2 * vc;
                    float a[4];
#pragma unroll
                    for (int i = 0; i < 4; ++i) a[i] = cgt[i] * sigmoidf_(cgt[i]) * cvl[i];
                    u32x2 w; w.x = pk2(a[0], a[1]); w.y = pk2(a[2], a[3]);
                    *(u32x2*)(A + (size_t)(u.pm * BM + ai * 128 + wr * 64 + 4 * fr + m) * DFF + ch) = w;
                    pg2 = pg1; pg1 = gc; pv2 = pv1; pv1 = vc;
                }
                asm volatile("" ::: "memory");
            }
        }
        if (has_next) {
            prm[(slot ^ 1) * 1024 + tid] = nx0; prm[(slot ^ 1) * 1024 + tid + 512] = nx1;
            if (tid < 256) rsd[(slot ^ 1) * 256 + tid] = fast_rsq(nrs * (1.0f / DM) + EPS);
        }
    }
};
template <class Epi, class Sched, bool ALIGN_EPI = false, bool SP2 = false>
__device__ __forceinline__ void gemm_phase(PG8_LAS unsigned char* lds, const Gemm g, const Sched& S, const Epi& E, const int tid_arg) {
    int tid_l = tid_arg; asm volatile("" : "+v"(tid_l));
    const int tid = tid_l, wid = __builtin_amdgcn_readfirstlane(tid >> 6), lane = tid & 63, wr = wid >> 2, wc = wid & 3, fr = lane & 15, fq = lane >> 4;
    const int K = g.K, nt = K / BK;
    unsigned voffA[2], voffB[2];
#pragma unroll
    for (int i = 0; i < 2; ++i) { int R, C; stage_rc(tid * 16 + i * 8192, R, C); const int Rb = Epi::PERM ? ((R & ~31) + perm32(R & 31)) : R;
        const int Ra = Epi::PERMA ? ((R & ~63) + 4 * (R & 15) + ((R >> 4) & 3)) : R;
        voffA[i] = (unsigned)(Ra * K + C) * 2u; voffB[i] = (unsigned)(Rb * K + C) * 2u; }
    const size_t kstep = (size_t)(BK * 2);
    const size_t hstep = (size_t)HALF * K * 2;
    const size_t tstep = 2 * hstep;
    const unsigned ldsw = (unsigned)wid * 1024u;
    const int aoff = lds_byte(wr * 64 + fr, fq * 8), boff = lds_byte(wc * 32 + fr, fq * 8);
#define PG8_SA(b, h) (((b) * 2 + (h)) * HTB)
#define PG8_SB(b, h) ((4 + (b) * 2 + (h)) * HTB)
#define PG8_STAGE(bufoff, gbase, voff) do { _Pragma("unroll") for (int _i = 0; _i < 2; ++_i) \
        __builtin_amdgcn_global_load_lds((const unsigned*)((const char*)(gbase) + (voff)[_i]), (PG8_LAS unsigned*)(lds + (bufoff) + ldsw + _i * 8192), 16, 0, 0); } while (0)
#define PG8_LDA(dst, b, h) do { _Pragma("unroll") for (int m = 0; m < 4; ++m) _Pragma("unroll") for (int k = 0; k < 2; ++k) dst[m][k] = *(const PG8_LAS bf16x8*)(lds + PG8_SA(b, h) + aoff + m * 2048 + k * 1024); } while (0)
#define PG8_LDB(dst, b, h) do { _Pragma("unroll") for (int n = 0; n < 2; ++n) _Pragma("unroll") for (int k = 0; k < 2; ++k) dst[n][k] = *(const PG8_LAS bf16x8*)(lds + PG8_SB(b, h) + boff + n * 2048 + k * 1024); } while (0)
#define PG8_MMA(ai, bj, At, Bt) do { __builtin_amdgcn_s_setprio(1); _Pragma("unroll") for (int m = 0; m < 4; ++m) _Pragma("unroll") for (int n = 0; n < 2; ++n) _Pragma("unroll") for (int k = 0; k < 2; ++k) \
        acc[ai][bj][m][n] = __builtin_amdgcn_mfma_f32_16x16x32_bf16(Bt[n][k], At[m][k], acc[ai][bj][m][n], 0, 0, 0); __builtin_amdgcn_s_setprio(0); } while (0)
#define PG8_WAIT_V(n) asm volatile("s_waitcnt vmcnt(" #n ")" ::: "memory")
#define PG8_WAIT_L(n) asm volatile("s_waitcnt lgkmcnt(" #n ")" ::: "memory")
#define PG8_BAR __builtin_amdgcn_s_barrier()
#define PG8_SCHED __builtin_amdgcn_sched_barrier(0)
    Unit cur, nxt; int ui = 0;
    if (!S.next(0, cur)) return;
    f32x4 acc[2][2][4][2];
#pragma unroll
    for (int a = 0; a < 2; ++a)
#pragma unroll
        for (int b = 0; b < 2; ++b)
#pragma unroll
            for (int m = 0; m < 4; ++m)
#pragma unroll
                for (int n = 0; n < 2; ++n) acc[a][b][m][n] = (f32x4){0.f, 0.f, 0.f, 0.f};
    bf16x8 At[4][2], B0[2][2], B1[2][2];
    const char* cA = (const char*)g.A + (size_t)cur.pm * tstep; const char* cB = (const char*)g.Bt + (size_t)cur.pn * tstep;
    S.a_ready(cur);
    if constexpr (SP2) {
        PG8_STAGE(PG8_SB(0, 0), cB, voffB); PG8_STAGE(PG8_SB(0, 1), cB + hstep, voffB); PG8_STAGE(PG8_SA(0, 0), cA, voffA); PG8_STAGE(PG8_SA(0, 1), cA + hstep, voffA);
        if (wr == 1) PG8_BAR;
        PG8_WAIT_V(2); PG8_BAR;
        PG8_STAGE(PG8_SB(1, 0), cB + kstep, voffB); PG8_STAGE(PG8_SA(1, 0), cA + kstep, voffA); PG8_STAGE(PG8_SB(1, 1), cB + hstep + kstep, voffB);
        PG8_WAIT_V(6); PG8_BAR;
    } else {
        PG8_STAGE(PG8_SB(0, 0), cB, voffB); PG8_STAGE(PG8_SA(0, 0), cA, voffA); PG8_STAGE(PG8_SB(0, 1), cB + hstep, voffB); PG8_STAGE(PG8_SA(0, 1), cA + hstep, voffA);
        if (wr == 1) PG8_BAR;
        PG8_WAIT_V(4); PG8_BAR;
        PG8_STAGE(PG8_SB(1, 0), cB + kstep, voffB); PG8_STAGE(PG8_SA(1, 0), cA + kstep, voffA); PG8_STAGE(PG8_SB(1, 1), cB + hstep + kstep, voffB);
        PG8_WAIT_V(6); PG8_BAR;
    }
    for (;;) {
        const bool has_next = S.next(ui + 1, nxt);
        const char* nA = has_next ? (const char*)g.A + (size_t)nxt.pm * tstep : cA; const char* nB = has_next ? (const char*)g.Bt + (size_t)nxt.pn * tstep : cB;
        for (int t = 0; t < nt; t += 2) {
            const bool last = (t == nt - 2);
            const char* a1 = cA + (size_t)(t + 1) * kstep;
            const char* a2 = last ? nA : cA + (size_t)(t + 2) * kstep; const char* b2 = last ? nB : cB + (size_t)(t + 2) * kstep;
            const char* a3 = a2 + kstep; const char* b3 = b2 + kstep;
            if (last && has_next) S.a_ready(nxt);
            if constexpr (SP2) {
            PG8_LDB(B0, 0, 0); PG8_LDB(B1, 0, 1); PG8_SCHED; PG8_LDA(At, 0, 0); PG8_STAGE(PG8_SA(1, 1), a1 + hstep, voffA);
            PG8_WAIT_V(8); PG8_WAIT_L(0); PG8_BAR; PG8_MMA(0, 0, At, B0); PG8_MMA(0, 1, At, B1); PG8_BAR; PG8_SCHED;
            PG8_LDA(At, 0, 1); PG8_STAGE(PG8_SB(0, 0), b2, voffB); PG8_STAGE(PG8_SB(0, 1), b2 + hstep, voffB); PG8_STAGE(PG8_SA(0, 0), a2, voffA);
            PG8_WAIT_V(8); PG8_WAIT_L(0); PG8_BAR; PG8_MMA(1, 0, At, B0); PG8_MMA(1, 1, At, B1); PG8_BAR; PG8_SCHED;
            PG8_LDB(B0, 1, 0); PG8_LDB(B1, 1, 1); PG8_SCHED; PG8_LDA(At, 1, 0); PG8_STAGE(PG8_SA(0, 1), a2 + hstep, voffA);
            PG8_WAIT_V(8); PG8_WAIT_L(0); PG8_BAR; PG8_MMA(0, 0, At, B0); PG8_MMA(0, 1, At, B1); PG8_BAR; PG8_SCHED;
            PG8_LDA(At, 1, 1); PG8_STAGE(PG8_SB(1, 0), b3, voffB); PG8_STAGE(PG8_SB(1, 1), b3 + hstep, voffB); PG8_STAGE(PG8_SA(1, 0), a3, voffA);
            PG8_WAIT_V(8); PG8_WAIT_L(0); PG8_BAR; PG8_MMA(1, 0, At, B0); PG8_MMA(1, 1, At, B1); PG8_BAR; PG8_SCHED;
            } else {
            PG8_LDB(B0, 0, 0); PG8_SCHED; PG8_LDA(At, 0, 0); PG8_STAGE(PG8_SA(1, 1), a1 + hstep, voffA);
            PG8_WAIT_L(8); PG8_BAR; PG8_WAIT_L(0); PG8_MMA(0, 0, At, B0); PG8_BAR; PG8_SCHED;
            PG8_LDB(B1, 0, 1); PG8_STAGE(PG8_SB(0, 0), b2, voffB);
            PG8_BAR; PG8_WAIT_L(0); PG8_MMA(0, 1, At, B1); PG8_BAR;
            PG8_LDA(At, 0, 1); PG8_STAGE(PG8_SA(0, 0), a2, voffA);
            PG8_BAR; PG8_WAIT_L(0); PG8_MMA(1, 0, At, B0); PG8_BAR; PG8_SCHED;
            PG8_STAGE(PG8_SB(0, 1), b2 + hstep, voffB);
            PG8_WAIT_V(6); PG8_BAR; PG8_MMA(1, 1, At, B1); PG8_BAR;
            PG8_LDB(B0, 1, 0); PG8_SCHED; PG8_LDA(At, 1, 0); PG8_STAGE(PG8_SA(0, 1), a2 + hstep, voffA);
            PG8_WAIT_L(8); PG8_BAR; PG8_WAIT_L(0); PG8_MMA(0, 0, At, B0); PG8_BAR; PG8_SCHED;
            PG8_LDB(B1, 1, 1); PG8_STAGE(PG8_SB(1, 0), b3, voffB);
            PG8_BAR; PG8_WAIT_L(0); PG8_MMA(0, 1, At, B1); PG8_BAR;
            PG8_LDA(At, 1, 1); PG8_STAGE(PG8_SA(1, 0), a3, voffA);
            PG8_BAR; PG8_WAIT_L(0); PG8_MMA(1, 0, At, B0); PG8_BAR; PG8_SCHED;
            PG8_STAGE(PG8_SB(1, 1), b3 + hstep, voffB);
            PG8_WAIT_V(6); PG8_BAR; PG8_MMA(1, 1, At, B1); PG8_BAR;
            }
        }
        if constexpr (ALIGN_EPI) { if (wr == 0) PG8_BAR; }
        if constexpr (!Epi::AFTER_DRAIN) { if constexpr (Epi::WANTS_NEXT) E.run(acc, cur, nxt, has_next, ui, wr, wc, fr, fq); else E(acc, cur, wr, wc, fr, fq); S.done(cur); }
        if (!has_next) break;
#pragma unroll
        for (int a = 0; a < 2; ++a)
#pragma unroll
            for (int b = 0; b < 2; ++b)
#pragma unroll
                for (int m = 0; m < 4; ++m)
#pragma unroll
                    for (int n = 0; n < 2; ++n) acc[a][b][m][n] = (f32x4){0.f, 0.f, 0.f, 0.f};
        cur = nxt; cA = nA; cB = nB; ++ui;
        if constexpr (ALIGN_EPI) { if (wr == 1) PG8_BAR; }
    }
    PG8_WAIT_V(0);
    if constexpr (!ALIGN_EPI) { if (wr == 0) PG8_BAR; }
    PG8_BAR;
    if constexpr (Epi::AFTER_DRAIN) { E.fused(acc, cur, wr, wc, fr, fq, lds, wid, lane); S.done(cur); }
#undef PG8_SA
#undef PG8_SB
#undef PG8_STAGE
#undef PG8_LDA
#undef PG8_LDB
#undef PG8_MMA
#undef PG8_WAIT_V
#undef PG8_WAIT_L
#undef PG8_BAR
#undef PG8_SCHED
}
}
template <int MODE> __device__ __forceinline__ int srccol(int n) {
    if (MODE == 1) {
        const int ct = n & 255, lg = (n & ~255) + ((ct >> 5) & 3) * 64 + (ct >> 7) * 32 + (ct & 31);
        return lg < 2432 ? lg : lg + 6; }
    if (MODE == 2) { const int pn = n >> 8, j = n & 255; return j < 128 ? 128 * pn + j : DFF + 128 * pn + (j - 128); }
    return n;
}
template <int MODE> __device__ __forceinline__ void transpose_item(const float* W, int K, int Nsrc, int Ndst, bf16_t* WT, LAS float* scr, int item, int lane, const float* kgain = nullptr) {
    const int nblk = Ndst / 32, kb = item / nblk, nb = item % nblk, k0 = 64 * kb, n0 = 32 * nb;
    const int sc = srccol<MODE>(n0 + (lane & 31));
#pragma unroll
    for (int i = 0; i < 32; ++i) { const int kk = 2 * i + (lane >> 5); scr[kk * 33 + (lane & 31)] = W[(size_t)(k0 + kk) * Nsrc + sc] * (kgain ? kgain[k0 + kk] : 1.0f); }
    asm volatile("s_waitcnt lgkmcnt(0)" ::: "memory");
    const int c = lane & 7;
#pragma unroll
    for (int j = 0; j < 4; ++j) { const int n = (lane >> 3) + 8 * j; const LAS float* s = scr + (8 * c) * 33 + n;
        u32x4 o; o.x = pk2(s[0 * 33], s[1 * 33]); o.y = pk2(s[2 * 33], s[3 * 33]); o.z = pk2(s[4 * 33], s[5 * 33]); o.w = pk2(s[6 * 33], s[7 * 33]);
        *(u32x4*)(WT + (size_t)(n0 + n) * K + k0 + 8 * c) = o; }
    asm volatile("s_waitcnt lgkmcnt(0)" ::: "memory");
}

template <bool FG, bool BIN = false> __device__ __forceinline__ void norm_phase(const float* hin, const float* gain, bf16_t* out, const float* win, const float* fbias, float* logf, int gw, int NGW, int lane) {
    float g[16];
#pragma unroll
    for (int i = 0; i < 2; ++i) { const int c0 = 8 * (lane + 64 * i); const f32x4 a = *(const f32x4*)(gain + c0), b = *(const f32x4*)(gain + c0 + 4);
        g[8 * i + 0] = a[0]; g[8 * i + 1] = a[1]; g[8 * i + 2] = a[2]; g[8 * i + 3] = a[3]; g[8 * i + 4] = b[0]; g[8 * i + 5] = b[1]; g[8 * i + 6] = b[2]; g[8 * i + 7] = b[3]; }
    float wf[6][16]; float fb[6];
    if (FG) {
#pragma unroll
        for (int i = 0; i < 2; ++i)
#pragma unroll
            for (int e = 0; e < 8; ++e) { const float* wp = win + (size_t)(8 * (lane + 64 * i) + e) * INC + 2432;
#pragma unroll
                for (int j = 0; j < 6; ++j) wf[j][8 * i + e] = wp[j] * g[8 * i + e]; }
#pragma unroll
        for (int j = 0; j < 6; ++j) fb[j] = fbias[j];
    }
    f32x4 nx[4];
    const bf16_t* hbin = (const bf16_t*)hin;
#define NORM_LD(rowi) do { _Pragma("unroll") for (int i = 0; i < 2; ++i) { const int c0 = 8 * (lane + 64 * i); \
        if (BIN) { const u32x4 q_ = *(const u32x4*)(hbin + (size_t)(rowi) * DM + c0); \
            nx[2 * i] = (f32x4){__uint_as_float(q_.x << 16), __uint_as_float(q_.x & 0xffff0000u), __uint_as_float(q_.y << 16), __uint_as_float(q_.y & 0xffff0000u)}; \
            nx[2 * i + 1] = (f32x4){__uint_as_float(q_.z << 16), __uint_as_float(q_.z & 0xffff0000u), __uint_as_float(q_.w << 16), __uint_as_float(q_.w & 0xffff0000u)}; } \
        else { nx[2 * i] = *(const f32x4*)(hin + (size_t)(rowi) * DM + c0); nx[2 * i + 1] = *(const f32x4*)(hin + (size_t)(rowi) * DM + c0 + 4); } } } while (0)
    if (gw < T) NORM_LD(gw);
    for (int row = gw; row < T; row += NGW) {
        float x[16];
#pragma unroll
        for (int i = 0; i < 4; ++i) { x[4 * i + 0] = nx[i][0]; x[4 * i + 1] = nx[i][1]; x[4 * i + 2] = nx[i][2]; x[4 * i + 3] = nx[i][3]; }
        if (row + NGW < T) NORM_LD(row + NGW);
        float ss = 0.f;
#pragma unroll
        for (int e = 0; e < 16; ++e) ss += x[e] * x[e];
        ss = wave_sum(ss);
        const float rstd = fast_rsq(ss * (1.0f / DM) + EPS);
#pragma unroll
        for (int i = 0; i < 2; ++i) { u32x4 w;
            w.x = pk2(x[8 * i + 0] * rstd * g[8 * i + 0], x[8 * i + 1] * rstd * g[8 * i + 1]); w.y = pk2(x[8 * i + 2] * rstd * g[8 * i + 2], x[8 * i + 3] * rstd * g[8 * i + 3]);
            w.z = pk2(x[8 * i + 4] * rstd * g[8 * i + 4], x[8 * i + 5] * rstd * g[8 * i + 5]); w.w = pk2(x[8 * i + 6] * rstd * g[8 * i + 6], x[8 * i + 7] * rstd * g[8 * i + 7]);
            *(u32x4*)(out + (size_t)row * DM + 8 * (lane + 64 * i)) = w; }
        if (FG) {
            float mine = 0.f;
#pragma unroll
            for (int j = 0; j < 6; ++j) { float d = 0.f;
#pragma unroll
                for (int e = 0; e < 16; ++e) d += x[e] * wf[j][e];
                d = wave_sum(d) * rstd + fb[j];
                if (lane == j) mine = d; }
            if (lane < 6) { const float v = mine; logf[(size_t)row * 6 + lane] = fminf(v, 0.f) - log1pf(expf(-fabsf(v))); }
        }
    }
}

__device__ __forceinline__ void scan_unit(const float* logf, float* F2, int bh, LAS double* sd, int tid) {
    const int b = bh / 6, h = bh % 6;
    const float* src = logf + (size_t)b * SEQ * 6 + h;
    double loc[8]; double run = 0.0;
#pragma unroll
    for (int i = 0; i < 8; ++i) { run += (double)src[(size_t)(8 * tid + i) * 6]; loc[i] = run; }
    sd[tid] = run;
    __syncthreads();
    if (tid < 64) {
        double v[8], tot = 0.0;
#pragma unroll
        for (int k = 0; k < 8; ++k) { v[k] = tot; tot += sd[8 * tid + k]; }
        double inc = tot;
#pragma unroll
        for (int o = 1; o < 64; o <<= 1) {
            const int src = (tid >= o) ? tid - o : tid;
            const unsigned long long u_ = __builtin_bit_cast(unsigned long long, inc);
            const unsigned lo_ = (unsigned)__builtin_amdgcn_ds_bpermute(src << 2, (int)(unsigned)u_), hi_ = (unsigned)__builtin_amdgcn_ds_bpermute(src << 2, (int)(unsigned)(u_ >> 32));
            const double up = __builtin_bit_cast(double, ((unsigned long long)hi_ << 32) | lo_);
            if (tid >= o) inc += up;
        }
        const double base = inc - tot;
#pragma unroll
        for (int k = 0; k < 8; ++k) sd[8 * tid + k] = base + v[k];
    }
    __syncthreads();
    const double off = sd[tid];
#pragma unroll
    for (int i = 0; i < 8; ++i) F2[(size_t)bh * SEQ + 8 * tid + i] = (float)((off + loc[i]) * 1.4426950408889634);
    __syncthreads();
}

__device__ __forceinline__ void fix_rows(bf16_t* A, const float* edge, const float* cw, const float* cb, int pm, int tid) {
    const bool hasprev = (pm & 15) != 0;
#pragma unroll
    for (int it_ = 0; it_ < 6; ++it_) {
        const int ch = tid + 512 * it_; if (ch >= DFF) break;
        const int pn = ch >> 7, ci = ch & 127;
        const float* E = edge + (size_t)(pm * 22 + pn) * 1024;
        const float* P = hasprev ? edge + (size_t)((pm - 1) * 22 + pn) * 1024 : E;
        float c0[2], c1[2];
#pragma unroll
        for (int gv = 0; gv < 2; ++gv) {
            const int col = gv * 128 + ci, cc = gv * DFF + ch;
            const float u0 = E[col], u1 = E[256 + col], p254 = hasprev ? P[512 + col] : 0.f, p255 = hasprev ? P[768 + col] : 0.f;
            const float w0 = cw[cc], w1 = cw[UPN + cc], w2 = cw[2 * UPN + cc], bb = cb[cc];
            c0[gv] = bb + w0 * p254 + w1 * p255 + w2 * u0; c1[gv] = bb + w0 * p255 + w1 * u0 + w2 * u1;
        }
        const float a0 = c0[0] * sigmoidf_(c0[0]) * c0[1], a1 = c1[0] * sigmoidf_(c1[0]) * c1[1];
        A[(size_t)(pm * 256) * DFF + ch] = (bf16_t)(pk2(a0, 0.f) & 0xffffu);
        A[(size_t)(pm * 256 + 1) * DFF + ch] = (bf16_t)(pk2(a1, 0.f) & 0xffffu);
    }
}

struct AttnCtx { const bf16_t* Z; bf16_t* O; const float* F2; const float* rel; const float* subln; float lam, oml, Mb0, Mb1, Mb2; };
__device__ __forceinline__ int crow(int r, int hi) { return (r & 3) + 8 * (r >> 2) + 4 * hi; }
#define MFMA32(a, b, c) __builtin_amdgcn_mfma_f32_32x32x16_bf16((a), (b), (c), 0, 0, 0)
typedef short v4i16_t __attribute__((ext_vector_type(4)));
__device__ __forceinline__ s16x4 vtr(const LAS unsigned char* p) { return __builtin_bit_cast(s16x4, __builtin_amdgcn_ds_read_tr16_b64_v4i16((LAS v4i16_t*)p)); }

constexpr int AL_K = 0, AL_V = 32768, AL_F = 65536, AL_REL = 66560, AL_WS = 68608, AL_U = 69632;

template <int TYPE> __device__ __forceinline__ void attn_unit(const AttnCtx& C, int b, int h, int qb, LAS unsigned char* lds, int tid_in, unsigned* counter) {
    int tid = tid_in; asm volatile("" : "+v"(tid));
    const int lane = tid & 63, w = __builtin_amdgcn_readfirstlane(tid >> 6), r32 = lane & 31, hi = lane >> 5;
    const int cq = 4 * qb + (w >> 1);
    const float sl2 = (TYPE == 0) ? exp2f(-2.0f * (float)(h + 1)) * LOG2E : 0.f;
    const float dmax = (TYPE == 0) ? (160.0f + C.Mb0) / sl2 : 0.f;
    int t0 = 0; const int t1 = 4 * qb + 4;
    if (TYPE == 2) t0 = (4 * qb - 8 > 0) ? 4 * qb - 8 : 0;
    if (TYPE == 0) { const float num = (float)(256 * qb - 63) - dmax; if (num >= 0.f) t0 = (int)(num * (1.0f / 64.0f)) + 1; }
    int tfirst = 0;
    if (TYPE == 1) {
        const float* f2t = C.F2 + (size_t)(b * 6 + h) * SEQ;
        const float fend = f2t[64 * lane + 63];
        const float fq_unit = f2t[256 * qb], fq_wave = f2t[256 * qb + 32 * w];
        const unsigned long long need_u = __ballot(fq_unit - fend > -160.0f), need_w = __ballot(fq_wave - fend > -160.0f);
        t0 = need_u ? (int)__builtin_ctzll(need_u) : 0; tfirst = need_w ? (int)__builtin_ctzll(need_w) : 0;
        if (t0 > 4 * qb) t0 = 4 * qb;
    }
    t0 &= ~1;
    const int sq = 256 * qb + 32 * w + r32;
    const size_t rowb = (size_t)b * SEQ;
    LAS unsigned char* Kb = lds + AL_K; LAS unsigned char* Vb = lds + AL_V;
    LAS float* Fb = (LAS float*)(lds + AL_F); LAS float* relb = (LAS float*)(lds + AL_REL); LAS float* wscr = (LAS float*)(lds + AL_WS) + w * 32;
    constexpr int NPASS = (TYPE == 0) ? 2 : 1;
    unsigned nclaim = 0u;
    const float Mb = (TYPE == 0) ? C.Mb0 : (TYPE == 1) ? C.Mb1 : C.Mb2;
    const int kwoff = w * 1024 + lane * 16, vwoff = ((tid & 7) >> 2) * 4096 + (tid >> 3) * 64 + (tid & 3) * 16;
    const int vb0 = ((lane >> 4) & 1) * 32 + (lane & 3) * 8 + (4 * hi + ((lane & 15) >> 2)) * 64;
    f32x16 o[2], o1[2];
    if (TYPE == 2) { for (int i = tid; i < 257; i += 512) relb[i] = C.rel[h * 257 + i] * LOG2E; }
#pragma unroll
    for (int pass = 0; pass < NPASS; ++pass) {
        int qcol, kcol, vcol;
        if (TYPE == 0) { qcol = pass * 256 + 64 * h; kcol = 512 + pass * 256 + 64 * h; vcol = 1024 + 64 * h; }
        else if (TYPE == 1) { qcol = 1280 + 64 * h; kcol = 1664 + 64 * h; vcol = 2048 + 64 * h; }
        else { qcol = 2432 + 64 * h; kcol = 2816 + 64 * h; vcol = 3200 + 64 * h; }
        const bf16_t* Qp = C.Z + (rowb + sq) * ZP + qcol + 8 * hi;
        bf16x8 qr[4];
#pragma unroll
        for (int d0 = 0; d0 < 4; ++d0) qr[d0] = *(const bf16x8*)(Qp + 16 * d0);
        float cinit = -Mb;
        const float* f2p = C.F2 + (size_t)(b * 6 + h) * SEQ;
        if (TYPE == 1) cinit += f2p[sq];
        f32x16 cvec, zvec;
#pragma unroll
        for (int r = 0; r < 16; ++r) { cvec[r] = cinit; zvec[r] = 0.f; }
#pragma unroll
        for (int r = 0; r < 16; ++r) { o[0][r] = 0.f; o[1][r] = 0.f; }
        float lsum = 0.f;
        const bf16_t* kg = C.Z + (rowb + lane) * ZP + kcol + 8 * w;
        const bf16_t* vg = C.Z + (rowb + (tid >> 3)) * ZP + vcol + 8 * (tid & 7);
        u32x4 kreg = *(const u32x4*)(kg + (size_t)t0 * 64 * ZP), vreg = *(const u32x4*)(vg + (size_t)t0 * 64 * ZP);
        u32x4 kreg2 = *(const u32x4*)(kg + (size_t)(t0 + 1) * 64 * ZP), vreg2 = *(const u32x4*)(vg + (size_t)(t0 + 1) * 64 * ZP);
        float freg = 0.f, freg2 = 0.f;
        if (TYPE == 1 && tid < 64) { freg = f2p[t0 * 64 + tid]; freg2 = f2p[(t0 + 1) * 64 + tid]; }
        __syncthreads();
        for (int t = t0; t < t1; ++t) {
            const int bo = (t & 3) * 8192;
            if ((t & 1) == 0) {
                const int bo1 = ((t + 1) & 3) * 8192;
                *(LAS u32x4*)(Kb + bo + kwoff) = kreg; *(LAS u32x4*)(Vb + bo + vwoff) = vreg;
                *(LAS u32x4*)(Kb + bo1 + kwoff) = kreg2; *(LAS u32x4*)(Vb + bo1 + vwoff) = vreg2;
                if (TYPE == 1 && tid < 64) { Fb[(t & 3) * 64 + tid] = freg; Fb[((t + 1) & 3) * 64 + tid] = freg2; }
                if (t + 2 < t1) {
                    kreg = *(const u32x4*)(kg + (size_t)(t + 2) * 64 * ZP); vreg = *(const u32x4*)(vg + (size_t)(t + 2) * 64 * ZP);
                    kreg2 = *(const u32x4*)(kg + (size_t)(t + 3) * 64 * ZP); vreg2 = *(const u32x4*)(vg + (size_t)(t + 3) * 64 * ZP);
                    if (TYPE == 1 && tid < 64) { freg = f2p[(t + 2) * 64 + tid]; freg2 = f2p[(t + 3) * 64 + tid]; }
                }
                if (pass == NPASS - 1 && t + 2 >= t1 && tid == 0) nclaim = atomicAdd(counter, 1u);
                __syncthreads();
            }
            const bool active = (TYPE == 2) ? (t >= cq - 8 && t <= cq) : (TYPE == 0) ? (t <= cq && (float)(256 * qb + 32 * w - 64 * t - 63) < dmax) : (t <= cq && t >= tfirst);
            if (active) {
                f32x16 p0, p1;
                const LAS unsigned char* kp = Kb + bo + hi * 1024 + r32 * 16;
#pragma unroll
                for (int d0 = 0; d0 < 4; ++d0) {
                    const bf16x8 a0 = *(const LAS bf16x8*)(kp + d0 * 2048), a1 = *(const LAS bf16x8*)(kp + d0 * 2048 + 512);
                    if (d0 == 0) { p0 = MFMA32(a0, qr[0], (TYPE == 1 ? cvec : zvec)); p1 = MFMA32(a1, qr[0], (TYPE == 1 ? cvec : zvec)); }
                    else { p0 = MFMA32(a0, qr[d0], p0); p1 = MFMA32(a1, qr[d0], p1); }
                }
                const int xi = sq - 64 * t - 4 * hi;
                if (TYPE == 0) {
                    const float xf = (float)xi;
#pragma unroll
                    for (int r = 0; r < 16; ++r) { const float c = (float)((r & 3) + 8 * (r >> 2));
                        p0[r] = fast_exp2(p0[r] - sl2 * fabsf(xf - c)); p1[r] = fast_exp2(p1[r] - sl2 * fabsf(xf - (c + 32.f))); }
                } else if (TYPE == 1) {
                    const LAS float* fp = Fb + (t & 3) * 64 + 4 * hi;
#pragma unroll
                    for (int g = 0; g < 4; ++g) { const f32x4 fa = *(const LAS f32x4*)(fp + 8 * g), fb2 = *(const LAS f32x4*)(fp + 32 + 8 * g);
#pragma unroll
                        for (int i = 0; i < 4; i += 2) {
                            const f32x2_t d0_ = (f32x2_t){p0[4 * g + i], p0[4 * g + i + 1]} - (f32x2_t){fa[i], fa[i + 1]}, d1_ = (f32x2_t){p1[4 * g + i], p1[4 * g + i + 1]} - (f32x2_t){fb2[i], fb2[i + 1]};
                            p0[4 * g + i] = fast_exp2(d0_[0]); p0[4 * g + i + 1] = fast_exp2(d0_[1]); p1[4 * g + i] = fast_exp2(d1_[0]); p1[4 * g + i + 1] = fast_exp2(d1_[1]); } }
                    if (t == cq) { const int qrel = 32 * (w & 1) + r32;
#pragma unroll
                        for (int r = 0; r < 16; ++r) { const int kv = crow(r, hi); if (kv > qrel) p0[r] = 0.f; if (kv + 32 > qrel) p1[r] = 0.f; } }
                } else {
                    if (cq - t >= 3) { const float bc = relb[256];
#pragma unroll
                        for (int r = 0; r < 16; ++r) { p0[r] = fast_exp2(p0[r] + bc); p1[r] = fast_exp2(p1[r] + bc); }
                    } else {
#pragma unroll
                        for (int r = 0; r < 16; ++r) { const int c = (r & 3) + 8 * (r >> 2);
                            int i0 = xi - c; i0 = i0 < -128 ? -128 : (i0 > 128 ? 128 : i0); int i1 = xi - c - 32; i1 = i1 < -128 ? -128 : (i1 > 128 ? 128 : i1);
                            p0[r] = fast_exp2(p0[r] + relb[i0 + 128]); p1[r] = fast_exp2(p1[r] + relb[i1 + 128]); }
                    }
                }
                f32x2_t a2 = {0.f, 0.f};
#pragma unroll
                for (int r = 0; r < 16; r += 2) { a2 += (f32x2_t){p0[r], p0[r + 1]}; a2 += (f32x2_t){p1[r], p1[r + 1]}; }
                lsum += a2[0] + a2[1];
                bf16x8 pa[4];
#pragma unroll
                for (int s = 0; s < 2; ++s) {
                    u32x4 a, c2;
                    a.x = pk2(p0[8 * s + 0], p0[8 * s + 1]); a.y = pk2(p0[8 * s + 2], p0[8 * s + 3]); a.z = pk2(p0[8 * s + 4], p0[8 * s + 5]); a.w = pk2(p0[8 * s + 6], p0[8 * s + 7]);
                    c2.x = pk2(p1[8 * s + 0], p1[8 * s + 1]); c2.y = pk2(p1[8 * s + 2], p1[8 * s + 3]); c2.z = pk2(p1[8 * s + 4], p1[8 * s + 5]); c2.w = pk2(p1[8 * s + 6], p1[8 * s + 7]);
                    pa[s] = __builtin_bit_cast(bf16x8, a); pa[2 + s] = __builtin_bit_cast(bf16x8, c2);
                }
                const LAS unsigned char* vp = Vb + bo + vb0;
#pragma unroll
                for (int dh = 0; dh < 2; ++dh)
#pragma unroll
                    for (int ks = 0; ks < 4; ++ks) {
                        const s16x4 lo = vtr(vp + dh * 4096 + ks * 1024), hh = vtr(vp + dh * 4096 + ks * 1024 + 512);
                        const bf16x8 vf = {lo[0], lo[1], lo[2], lo[3], hh[0], hh[1], hh[2], hh[3]};
                        o[dh] = MFMA32(pa[ks], vf, o[dh]);
                    }
            }
        }
        const float ltot = xor32_sum(lsum);
        if (hi == 0) wscr[r32] = 1.0f / ltot;
#pragma unroll
        for (int g = 0; g < 4; ++g) { const f32x4 iv = *(const LAS f32x4*)(wscr + 8 * g + 4 * hi);
#pragma unroll
            for (int i = 0; i < 4; ++i) { o[0][4 * g + i] *= iv[i]; o[1][4 * g + i] *= iv[i]; } }
        if (TYPE == 0) {
            if (pass == 0) { o1[0] = o[0]; o1[1] = o[1]; }
            else {
#pragma unroll
                for (int r = 0; r < 16; ++r) { o[0][r] = o1[0][r] - C.lam * o[0][r]; o[1][r] = o1[1][r] - C.lam * o[1][r]; }
            }
        }
    }
    int ocol;
    if (TYPE == 0) {
        ocol = 64 * h;
        const float g0 = C.subln[r32], g1 = C.subln[32 + r32];
#pragma unroll
        for (int r = 0; r < 16; ++r) {
            float ss = o[0][r] * o[0][r] + o[1][r] * o[1][r];
            ss = xor16_sum(row16_sum(ss));
            const float rs = C.oml * fast_rsq(ss * (1.0f / 64.0f) + EPS);
            o[0][r] *= rs * g0; o[1][r] *= rs * g1;
        }
    } else if (TYPE == 1) ocol = 256 + 64 * h; else ocol = 640 + 64 * h;
    bf16_t* Op = C.O + (rowb + 256 * qb + 32 * w) * DM + ocol + r32;
#pragma unroll
    for (int r = 0; r < 16; ++r) {
        const size_t ro = (size_t)crow(r, hi) * DM;
        Op[ro] = (bf16_t)(pk2(o[0][r], 0.f) & 0xffffu); Op[ro + 32] = (bf16_t)(pk2(o[1][r], 0.f) & 0xffffu);
    }
    if (tid == 0) ((LAS unsigned*)(lds + AL_U))[0] = nclaim;
}

constexpr int ATT_UNITS = 2048;
__device__ __forceinline__ void attn_phase(const AttnCtx& C, unsigned* counter, LAS unsigned char* lds, int tid) {
    LAS unsigned* ub = (LAS unsigned*)(lds + AL_U);
    __syncthreads();
    if (tid == 0) ub[0] = atomicAdd(counter, 1u);
    for (;;) {
        __syncthreads();
        const int u = (int)ub[0];
        if (u >= ATT_UNITS) break;
        int ty, ub_, uh, uq;
        if (u < 256) { ty = 0; ub_ = (u & 31) >> 2; uh = u & 3; uq = 15 - (u >> 5); }
        else if (u < 1280) { const int v = u - 256, q = 7 - (v >> 7), wv = v & 127;
            if (wv < 32) { ty = 0; ub_ = wv >> 2; uh = wv & 3; uq = q; }
            else if (wv < 80) { ty = 1; ub_ = (wv - 32) / 6; uh = (wv - 32) % 6; uq = 2 * q + 1; }
            else { ty = 1; ub_ = (wv - 80) / 6; uh = (wv - 80) % 6; uq = 2 * q; } }
        else { const int v = u - 1280; ty = 2; ub_ = (v % 48) / 6; uh = (v % 48) % 6; uq = 15 - v / 48; }
        if (ty == 0) attn_unit<0>(C, ub_, uh, uq, lds, tid, counter);
        else if (ty == 1) attn_unit<1>(C, ub_, uh, uq, lds, tid, counter);
        else attn_unit<2>(C, ub_, uh, uq, lds, tid, counter);
    }
}
struct Args { const float* in[18]; float* out; unsigned char* ws; };
constexpr int LDS_TOTAL = 149760, LDS_XCH = 131072, LDS_PRM = LDS_XCH + 8256, LDS_RSD = LDS_PRM + 8192;
#ifdef PROBE_SYNC2
#define GSYNC() do { xcd_barrier(xbar, K_TID == 0); xcd_barrier(xbar, K_TID == 0); } while (0)
#else
#define GSYNC() xcd_barrier(xbar, K_TID == 0)
#endif
__device__ __forceinline__ int lane_fresh() { unsigned m = ~0u; asm volatile("" : "+s"(m)); int t = (int)__builtin_amdgcn_mbcnt_hi(m, __builtin_amdgcn_mbcnt_lo(m, 0u)); asm volatile("" : "+v"(t)); return t; }
typedef const __attribute__((address_space(4))) Args* kargs_t;
__device__ __forceinline__ kargs_t kargs() { kargs_t p = (kargs_t)__builtin_amdgcn_kernarg_segment_ptr(); asm volatile("" : "+s"(p)); return p; }
#define AIN(i) (kargs()->in[i])
#define AOUT (kargs()->out)
#define AWS (kargs()->ws)
#define P_HN ((bf16_t*)(AWS + WS_HN))
#define P_Zb ((bf16_t*)(AWS + WS_Z))
#define P_LOGF ((float*)(AWS + WS_LOGF))
#define P_F2 ((float*)(AWS + WS_F2))
#define P_EDGE ((float*)(AWS + WS_EDGE))
#define P_PB ((bf16_t*)(AWS + WS_PB))
#define P_HB ((bf16_t*)(AWS + WS_HB))
#define P_RSQ ((u64_t*)(AWS + WS_RSQ))

__global__ void __launch_bounds__(512, 2) fwd_megakernel(Args a) {
    __shared__ __attribute__((aligned(16))) unsigned char lds_raw[LDS_TOTAL];
    cg::grid_group grid = cg::this_grid();
    LAS unsigned char* lds = (LAS unsigned char*)lds_raw;
    const int G = gridDim.x, bx = blockIdx.x, NGW = G * 8;
    const int wave_s = __builtin_amdgcn_readfirstlane((int)threadIdx.x >> 6);
#define K_TID ((wave_s << 6) | lane_fresh())
#define K_LANE (lane_fresh())
#define K_WAVE (wave_s)
#define K_GW (bx * 8 + K_WAVE)
    volatile LAS unsigned* xst = (volatile LAS unsigned*)(lds + LDS_XCH + 8192);
    if (K_TID < 4) xst[K_TID] = 0u;
    __syncthreads();
    XcdBarrier xbar = xcd_barrier_post((unsigned*)(AWS + WS_CTL), xst);
#ifdef PROBE_P0X2
    for (int rep_ = 0; rep_ < 2; ++rep_)
#endif
    {
        LAS float* scr = (LAS float*)(lds + K_WAVE * 8448);
        constexpr int I_IN = 16 * 112, I_OUT = 16 * 32, I_UP = 16 * 176, I_DN = 44 * 32, I_GT = 16 * 32, I_PJ = 4 * 32, I_L = I_IN + I_OUT + I_UP + I_DN + I_GT + I_PJ;
        for (int it = K_GW; it < 2 * I_L; it += NGW) {
            const int l = it / I_L; int r = it % I_L;
            if (r < I_IN) { transpose_item<1>(AIN(3) + (size_t)l * DM * INC, DM, INC, ZP, (bf16_t*)(AWS + WS_WIN + l * SZ_WIN), scr, r, K_LANE); continue; } r -= I_IN;
            if (r < I_OUT) { transpose_item<0>(AIN(9) + (size_t)l * DM * DM, DM, DM, DM, (bf16_t*)(AWS + WS_WOUT + l * SZ_WOUT), scr, r, K_LANE); continue; } r -= I_OUT;
            if (r < I_UP) { transpose_item<2>(AIN(11) + (size_t)l * DM * UPN, DM, UPN, UPN, (bf16_t*)(AWS + WS_WUP + l * SZ_WUP), scr, r, K_LANE, AIN(10) + l * DM); continue; } r -= I_UP;
            if (r < I_DN) { transpose_item<0>(AIN(14) + (size_t)l * DFF * DM, DFF, DM, DM, (bf16_t*)(AWS + WS_WDN + l * SZ_WDN), scr, r, K_LANE); continue; } r -= I_DN;
            if (r < I_GT) { transpose_item<0>(AIN(16) + (size_t)l * DM * DM, DM, DM, DM, (bf16_t*)(AWS + WS_WGT + l * SZ_WGT), scr, r, K_LANE, AIN(15) + l * DM); continue; } r -= I_GT;
            transpose_item<0>(AIN(17) + (size_t)l * PLED * DM, PLED, DM, DM, (bf16_t*)(AWS + WS_WPJ + l * SZ_WPJ), scr, r, K_LANE);
        }
        { unsigned* rq = (unsigned*)P_RSQ; for (int i = bx * 512 + K_TID; i < 8 * T; i += G * 512) rq[i] = 0u; }
        const size_t n8 = (size_t)2 * T * PLED / 8; const float* pp_ = AIN(1); bf16_t* pb_ = P_PB;
        for (size_t i = (size_t)bx * 512 + K_TID; i < n8; i += (size_t)G * 512) {
            const f32x4 v0 = *(const f32x4*)(pp_ + 8 * i), v1 = *(const f32x4*)(pp_ + 8 * i + 4);
            u32x4 w; w.x = pk2(v0[0], v0[1]); w.y = pk2(v0[2], v0[3]); w.z = pk2(v1[0], v1[1]); w.w = pk2(v1[2], v1[3]);
            *(u32x4*)(pb_ + 8 * i) = w;
        }
    }

    auto layer = [&](const int l) __attribute__((always_inline)) {

        {
#ifndef SKIP_NORMFG
            int lane_l = K_LANE, gw_l = K_GW; asm volatile("" : "+v"(lane_l), "+s"(gw_l));
#ifdef PROBE_P0X2
            for (int rep_ = 0; rep_ < 2; ++rep_)
#endif
            if (l == 0) norm_phase<true, false>(AIN(0), AIN(2) + l * DM, P_HN, AIN(3) + (size_t)l * DM * INC, AIN(7) + l * 6, P_LOGF, gw_l, NGW, lane_l);
            else norm_phase<true, true>((const float*)P_HB, AIN(2) + l * DM, P_HN, AIN(3) + (size_t)l * DM * INC, AIN(7) + l * 6, P_LOGF, gw_l, NGW, lane_l);
#endif
            if (l == 0 && gridDim.x > 1000000u) grid.sync();
            GSYNC();
        }
        {
#ifndef SKIP_SCAN
            if (bx < 48) { int tid_l = K_TID, bh_l = bx; asm volatile("" : "+v"(tid_l), "+s"(bh_l)); scan_unit(P_LOGF, P_F2, bh_l, (LAS double*)lds, tid_l); }
#endif
#ifndef SKIP_QKV
            pg8::Gemm g{P_HN, (const bf16_t*)(AWS + WS_WIN + l * SZ_WIN), T, ZP, DM}; pg8::StaticOrder S; S.init(T, ZP, G, bx);
            pg8::EpiQKV E{P_Zb, AIN(4) + l * 6 * 64};
#ifdef PROBE_PLAINQKV
            { pg8::EpiPlain EP{P_Zb}; pg8::gemm_phase<pg8::EpiPlain, pg8::StaticOrder, true, true>(lds, g, S, EP, K_TID); }
#endif
            pg8::gemm_phase<pg8::EpiQKV, pg8::StaticOrder, true, true>(lds, g, S, E, K_TID);
#ifdef PROBE_QKV2
            pg8::gemm_phase<pg8::EpiQKV, pg8::StaticOrder, true, true>(lds, g, S, E, K_TID);
#endif
#endif
        }
        GSYNC();
        {
            int lane_l = K_LANE, tid_l = K_TID; asm volatile("" : "+v"(lane_l), "+v"(tid_l));
            const float* gq = AIN(4) + l * 6 * 64;
            float mg[6];
#pragma unroll
            for (int j = 0; j < 6; ++j) mg[j] = wave_max(fabsf(gq[j * 64 + lane_l]));
            const float* rel = AIN(8) + l * 6 * 257;
            float mr = 0.f;
            for (int i = lane_l; i < 6 * 257; i += 64) mr = fmaxf(mr, fabsf(rel[i]));
            mr = wave_max(mr);
            const float* lp = AIN(5) + l * 4 * 64;
            const float s01 = wave_sum(lp[lane_l] * lp[64 + lane_l]), s23 = wave_sum(lp[128 + lane_l] * lp[192 + lane_l]);
            const float lam_init = (l == 0) ? 0.2f : (0.8f - 0.6f * 0.7408182206817179f);
            AttnCtx C;
            C.Z = P_Zb; C.O = P_HN; C.F2 = P_F2; C.rel = rel; C.subln = AIN(6) + l * 64;
            C.lam = expf(s01) - expf(s23) + lam_init; C.oml = 1.0f - lam_init;
            C.Mb0 = 8.0f * mg[0] * mg[1] * LOG2E * 1.02f + 1.0f; C.Mb1 = 8.0f * mg[2] * mg[3] * LOG2E * 1.02f + 1.0f; C.Mb2 = 8.0f * mg[4] * mg[5] * LOG2E * 1.02f + 1.0f + mr * LOG2E;
#ifndef SKIP_ATTN
            #define RFL(x) __uint_as_float(__builtin_amdgcn_readfirstlane(__float_as_uint(x)))
            C.lam = RFL(C.lam); C.oml = RFL(C.oml); C.Mb0 = RFL(C.Mb0); C.Mb1 = RFL(C.Mb1); C.Mb2 = RFL(C.Mb2);
            attn_phase(C, (unsigned*)(AWS + WS_CTL) + CTL_Q + 16 * (1 + l), lds, tid_l);
#ifdef PROBE_ATTN2
            attn_phase(C, (unsigned*)(AWS + WS_CTL) + CTL_Q + 16 * (1 + l) + 8, lds, tid_l);
#endif
#endif
        }
        GSYNC();
        {
            pg8::Gemm g{P_HN, (const bf16_t*)(AWS + WS_WOUT + l * SZ_WOUT), T, DM, DM}; pg8::StaticOrder S; S.init(T, DM, G, bx);
            pg8::EpiResid E{(l == 0) ? AIN(0) : (const float*)nullptr, P_HB, P_RSQ + (size_t)(2 * l) * T};
            pg8::gemm_phase<pg8::EpiResid, pg8::StaticOrder, true, true>(lds, g, S, E, K_TID);
        }
        GSYNC();
        {
            pg8::Gemm g{P_HB, (const bf16_t*)(AWS + WS_WUP + l * SZ_WUP), T, UPN, DM}; pg8::StaticOrder S; S.init(T, UPN, G, bx);
            pg8::EpiUp E{P_Zb, AIN(12) + (size_t)l * 3 * UPN, AIN(13) + l * UPN, P_EDGE, (LAS float*)(lds + LDS_XCH), P_RSQ + (size_t)(2 * l) * T, (LAS float*)(lds + LDS_PRM), (LAS float*)(lds + LDS_RSD)};
#ifndef SKIP_UP
            pg8::gemm_phase<pg8::EpiUp, pg8::StaticOrder, true, true>(lds, g, S, E, K_TID);
#ifdef PROBE_UP2
            pg8::gemm_phase<pg8::EpiUp, pg8::StaticOrder, true, true>(lds, g, S, E, K_TID);
#endif
#endif
        }
        GSYNC();
        {
            pg8::Gemm g{P_Zb, (const bf16_t*)(AWS + WS_WDN + l * SZ_WDN), T, DM, DFF}; pg8::StaticOrder S; S.init(T, DM, G, bx);
            pg8::Unit u;
            int tid_l = K_TID; asm volatile("" : "+v"(tid_l));
            for (int i = 0; S.next(i, u); ++i) fix_rows(P_Zb, P_EDGE, AIN(12) + (size_t)l * 3 * UPN, AIN(13) + l * UPN, u.pm, tid_l);
            __threadfence();
            __syncthreads();
            pg8::EpiResid E{nullptr, P_HB, P_RSQ + (size_t)(2 * l + 1) * T};
            pg8::gemm_phase<pg8::EpiResid, pg8::StaticOrder, true, true>(lds, g, S, E, K_TID);
        }
        GSYNC();
        {
            bf16_t* SG = P_Zb;
            pg8::StaticOrder S; S.init(T, DM, G, bx);
            { pg8::Gemm g{P_HB, (const bf16_t*)(AWS + WS_WGT + l * SZ_WGT), T, DM, DM}; pg8::EpiSig E{SG, P_RSQ + (size_t)(2 * l + 1) * T};
              pg8::gemm_phase<pg8::EpiSig, pg8::StaticOrder, true, true>(lds, g, S, E, K_TID);
#ifdef PROBE_SIG2
              pg8::gemm_phase<pg8::EpiSig, pg8::StaticOrder, true, true>(lds, g, S, E, K_TID);
#endif
            }
            GSYNC();
            { int kple = PLED; asm volatile("" : "+s"(kple));
              pg8::Gemm g{P_PB + (size_t)l * T * PLED, (const bf16_t*)(AWS + WS_WPJ + l * SZ_WPJ), T, DM, kple}; pg8::EpiMulAdd E{SG, P_HB, (l == 1) ? AOUT : (float*)nullptr};
              pg8::gemm_phase<pg8::EpiMulAdd, pg8::StaticOrder, true, true>(lds, g, S, E, K_TID); }
        }
        if (l == 0) GSYNC();
    };
    layer(0);
    layer(1);
}

extern "C" void kernel_launch(void* const* d_in, const int* in_sizes, int n_in, void* d_out, int out_size, void* d_ws, size_t ws_size, hipStream_t stream) {
    static int grid_blocks = 0;
    if (!grid_blocks) {
        int dev = 0, cus = 0, per_cu = 0;
        hipGetDevice(&dev);
        hipDeviceGetAttribute(&cus, hipDeviceAttributeMultiprocessorCount, dev);
        hipOccupancyMaxActiveBlocksPerMultiprocessor(&per_cu, fwd_megakernel, 512, 0);
        if (per_cu < 1) per_cu = 1;
        if (cus < 1) cus = 256;
        grid_blocks = cus * 1;
        if (n_in != 18 || ws_size < WS_END) fprintf(stderr, "kernel_launch: unexpected n_in %d or ws_size %zu (< %zu)\n", n_in, ws_size, (size_t)WS_END);
    }
    hipMemsetAsync(d_ws, 0, 16384, stream);
    Args a{};
    for (int i = 0; i < 18; ++i) a.in[i] = (const float*)d_in[i];
    a.out = (float*)d_out; a.ws = (unsigned char*)d_ws;
    void* args[] = {&a};
    hipError_t e = hipLaunchCooperativeKernel((void*)fwd_megakernel, dim3(grid_blocks), dim3(512), args, 0, stream);
    if (e != hipSuccess) fprintf(stderr, "cooperative launch failed: %s (grid %d)\n", hipGetErrorString(e), grid_blocks);
}
```

```cpp
#include <hip/hip_runtime.h>
#include <hip/hip_cooperative_groups.h>
#include <cstdio>
#include <cstdint>
namespace cg = cooperative_groups;

#define LAS __attribute__((address_space(3)))
typedef unsigned short bf16_t;
typedef short bf16x8 __attribute__((ext_vector_type(8)));
typedef short s16x4 __attribute__((ext_vector_type(4)));
typedef float f32x4 __attribute__((ext_vector_type(4)));
typedef float f32x16 __attribute__((ext_vector_type(16)));
typedef unsigned u32x4 __attribute__((ext_vector_type(4)));
typedef unsigned u32x2 __attribute__((ext_vector_type(2)));
typedef float f32x2_t __attribute__((ext_vector_type(2)));
typedef __bf16 bf16x2_t __attribute__((ext_vector_type(2)));

constexpr int NB = 8, SEQ = 4096, T = NB * SEQ, DM = 1024, ZP = 3584, DFF = 2816, UPN = 5632, PLED = 256, INC = 3590;
constexpr float EPS = 1e-6f, LOG2E = 1.4426950408889634f, C2 = 0.125f * 1.4426950408889634f;

constexpr size_t WS_CTL = 0;
constexpr size_t SZ_WIN = (size_t)ZP * DM * 2, SZ_WOUT = (size_t)DM * DM * 2, SZ_WUP = (size_t)UPN * DM * 2, SZ_WDN = (size_t)DM * DFF * 2, SZ_WGT = (size_t)DM * DM * 2, SZ_WPJ = (size_t)DM * PLED * 2;
constexpr size_t SZ_PB = (size_t)T * PLED * 2, SZ_HN = (size_t)T * DM * 2, SZ_Z = (size_t)T * ZP * 2, SZ_LOGF = (size_t)T * 6 * 4, SZ_EDGE = (size_t)128 * 22 * 1024 * 4;
constexpr size_t WS_WIN = 16384;
constexpr int CTL_Q = 3584;
constexpr size_t WS_WOUT = WS_WIN + 2 * SZ_WIN;
constexpr size_t WS_WUP = WS_WOUT + 2 * SZ_WOUT;
constexpr size_t WS_WDN = WS_WUP + 2 * SZ_WUP;
constexpr size_t WS_WGT = WS_WDN + 2 * SZ_WDN;
constexpr size_t WS_WPJ = WS_WGT + 2 * SZ_WGT;
constexpr size_t WS_PB = WS_WPJ + 2 * SZ_WPJ;
constexpr size_t WS_HN = WS_PB + 2 * SZ_PB;
constexpr size_t WS_Z = WS_HN + SZ_HN;
constexpr size_t WS_LOGF = WS_Z + SZ_Z;
constexpr size_t WS_F2 = WS_LOGF + SZ_LOGF;
constexpr size_t WS_EDGE = WS_F2 + SZ_LOGF;
constexpr size_t WS_HB = WS_EDGE + SZ_EDGE;
constexpr size_t WS_RSQ = WS_HB + SZ_HN;
constexpr size_t SZ_RSQ = (size_t)4 * T * 8;
constexpr size_t WS_END = WS_RSQ + SZ_RSQ;

__device__ __forceinline__ unsigned pk2(float lo, float hi) { f32x2_t v = {lo, hi}; bf16x2_t b = __builtin_convertvector(v, bf16x2_t); return __builtin_bit_cast(unsigned, b); }
#define DPPF(v, ctrl) __builtin_bit_cast(float, __builtin_amdgcn_update_dpp(0, __builtin_bit_cast(int, (v)), (ctrl), 0xf, 0xf, false))
__device__ __forceinline__ float xor16_sum(float v) { const auto r = __builtin_amdgcn_permlane16_swap(__float_as_uint(v), __float_as_uint(v), false, false); return __uint_as_float(r[0]) + __uint_as_float(r[1]); }
__device__ __forceinline__ float xor32_sum(float v) { const auto r = __builtin_amdgcn_permlane32_swap(__float_as_uint(v), __float_as_uint(v), false, false); return __uint_as_float(r[0]) + __uint_as_float(r[1]); }
__device__ __forceinline__ float xor16_max(float v) { const auto r = __builtin_amdgcn_permlane16_swap(__float_as_uint(v), __float_as_uint(v), false, false); return fmaxf(__uint_as_float(r[0]), __uint_as_float(r[1])); }
__device__ __forceinline__ float xor32_max(float v) { const auto r = __builtin_amdgcn_permlane32_swap(__float_as_uint(v), __float_as_uint(v), false, false); return fmaxf(__uint_as_float(r[0]), __uint_as_float(r[1])); }
__device__ __forceinline__ float row16_sum(float v) { v += DPPF(v, 0xB1); v += DPPF(v, 0x4E); v += DPPF(v, 0x141); v += DPPF(v, 0x140); return v; }
__device__ __forceinline__ float wave_sum(float v) { return xor32_sum(xor16_sum(row16_sum(v))); }
__device__ __forceinline__ float wave_max(float v) {
    v = fmaxf(v, DPPF(v, 0xB1)); v = fmaxf(v, DPPF(v, 0x4E)); v = fmaxf(v, DPPF(v, 0x141)); v = fmaxf(v, DPPF(v, 0x140));
    return xor32_max(xor16_max(v));
}
__device__ __forceinline__ float fast_exp2(float x) { return __builtin_amdgcn_exp2f(x); }
__device__ __forceinline__ float fast_rcp(float x) { return __builtin_amdgcn_rcpf(x); }
__device__ __forceinline__ float fast_rsq(float x) { return __builtin_amdgcn_rsqf(x); }
typedef unsigned long long u64_t;
__device__ __forceinline__ float rsq_sum(const u64_t* rsq, int row) { return (float)rsq[row] * (1.0f / 16777216.0f); }
__device__ __forceinline__ float row_rstd(const u64_t* rsq, int row) { return fast_rsq(rsq_sum(rsq, row) * (1.0f / DM) + EPS); }
__device__ __forceinline__ float sigmoidf_(float v) { return fast_rcp(1.0f + fast_exp2(-v * LOG2E)); }
#define XB_TMO      128
#define XB_XCNT(j)  (256  + 64 * (j))
#define XB_XSUB(j)  (1280 + 64 * (j))
#define XB_XGEN(j)  (2304 + 64 * (j))
#define XB_TOP      3328
#define XB_TOPGEN   3392
#define XCD_BAR_WORDS 3456
#define XB_SPIN_CAP (1u << 18)
__device__ __forceinline__ unsigned xb_ld(unsigned* p)              { return __hip_atomic_load(p, __ATOMIC_RELAXED, __HIP_MEMORY_SCOPE_AGENT); }
__device__ __forceinline__ unsigned xb_add(unsigned* p, unsigned v) { return __hip_atomic_fetch_add(p, v, __ATOMIC_RELAXED, __HIP_MEMORY_SCOPE_AGENT); }
__device__ __forceinline__ unsigned xb_xcc_id() { return (unsigned)__builtin_amdgcn_s_getreg((3 << 11) | 20) & 0xFu; }
#define XB_SPIN(cond, bar) do { unsigned _sp = 0; while (cond) { __builtin_amdgcn_s_sleep(1); \
    if ((++_sp & 255u) == 0u) { if (xb_ld(&(bar)[XB_TMO])) break; if (_sp > XB_SPIN_CAP) { atomicAdd(&(bar)[XB_TMO], 1u); break; } } } } while (0)

struct XcdBarrier {
    unsigned* bar; unsigned x;
    volatile LAS unsigned* st;
};

__device__ __forceinline__ XcdBarrier xcd_barrier_post(unsigned* bar, volatile LAS unsigned* st) {
    XcdBarrier b; b.bar = bar; b.x = xb_xcc_id(); b.st = st;
    if (threadIdx.x == 0) (void)xb_add(&bar[XB_XCNT(b.x)], 1u);
    return b;
}
__device__ __forceinline__ void xcd_barrier_complete(unsigned* bar, unsigned x, unsigned& nloc, unsigned& nx) {
    const unsigned G = gridDim.x * gridDim.y * gridDim.z;
    unsigned sum, cnt, mine, sp = 0u;
    for (;;) {
        sum = 0u; cnt = 0u; mine = 0u;
#pragma unroll
        for (unsigned j = 0; j < 16; ++j) { const unsigned c = xb_ld(&bar[XB_XCNT(j)]); sum += c; cnt += (c > 0u) ? 1u : 0u; mine = (j == x) ? c : mine; }
        if (sum == G) break;
        __builtin_amdgcn_s_sleep(1);
        if ((++sp & 255u) == 0u) { if (xb_ld(&bar[XB_TMO])) break; if (sp > XB_SPIN_CAP) { atomicAdd(&bar[XB_TMO], 1u); break; } }
    }
    nloc = mine > 0u ? mine : 1u; nx = cnt > 0u ? cnt : 1u;
}

__device__ __forceinline__ void xcd_barrier(const XcdBarrier& b, const bool xb_is_leader) {
    asm volatile("s_waitcnt vmcnt(0)" ::: "memory");
    __syncthreads();
    if (xb_is_leader) {
        unsigned* bar = b.bar;
        __builtin_amdgcn_s_waitcnt(0);
        unsigned nloc = b.st[0], nx = b.st[1];
        if (nloc == 0u) { xcd_barrier_complete(bar, b.x, nloc, nx); b.st[0] = nloc; b.st[1] = nx; }
        const unsigned old = xb_add(&bar[XB_XSUB(b.x)], 1u);
        const unsigned gen = old / nloc;
        if (old + 1u == (gen + 1u) * nloc) {
            __builtin_amdgcn_fence(__ATOMIC_RELEASE, "agent");
            asm volatile("s_waitcnt vmcnt(0)" ::: "memory");
            const unsigned og = xb_add(&bar[XB_TOP], 1u);
            const unsigned tg = og / nx;
            if (og + 1u == (tg + 1u) * nx) xb_add(&bar[XB_TOPGEN], 1u);
            else XB_SPIN(xb_ld(&bar[XB_TOPGEN]) == tg, bar);
            __builtin_amdgcn_fence(__ATOMIC_ACQUIRE, "agent");
            xb_add(&bar[XB_XGEN(b.x)], 1u);
            asm volatile("s_waitcnt vmcnt(0)" ::: "memory");
        } else {
            XB_SPIN(xb_ld(&bar[XB_XGEN(b.x)]) == gen, bar);
            __builtin_amdgcn_fence(__ATOMIC_ACQUIRE, "agent");
            asm volatile("s_waitcnt vmcnt(0)" ::: "memory");
        }
    }
    __syncthreads();
}
namespace pg8 {
#define PG8_LAS __attribute__((address_space(3)))
typedef unsigned short bf16_t;
typedef short bf16x8 __attribute__((ext_vector_type(8)));
typedef float f32x4 __attribute__((ext_vector_type(4)));
typedef unsigned u32x4 __attribute__((ext_vector_type(4)));
constexpr int BM = 256, BK = 64, HALF = 128, HTB = HALF * BK * 2  , STAGE_BYTES = 8 * HTB, NXCD = 8, WGM = 8;

__host__ __device__ __forceinline__ int lds_byte(int r, int c) { const int st = (r >> 4) * 2 + (c >> 5), rr = r & 15, cc = c & 31, ob = rr * 64 + cc * 2; return st * 1024 + (ob ^ (((ob >> 9) & 1) << 5)); }
__host__ __device__ __forceinline__ void stage_rc(int b, int& R, int& C) { const int st = b / 1024, sb = b % 1024, swz = sb ^ (((sb >> 9) & 1) << 5); R = (st >> 1) * 16 + swz / 64; C = (st & 1) * 32 + (swz % 64) / 2; }
__host__ __device__ __forceinline__ int perm32(int rho) { const int n = rho >> 4, i = rho & 15; return 8 * (i >> 2) + 4 * n + (i & 3); }

struct Unit { int pm, pn; };
struct Gemm { const bf16_t* A; const bf16_t* Bt; int M, N, K; };

struct StaticOrder {
    int nM, nN, nwg, G, c;
    __host__ __device__ void init(int M, int N, int G_, int c_) { nM = M / BM; nN = N / BM; nwg = nM * nN; G = G_; c = c_; }
    __host__ __device__ bool next(int i, Unit& u) const {
        const long L = (long)i * G + c; if (L >= nwg) return false;
        int wgid = (int)L; { const int q = nwg / NXCD, r = nwg % NXCD, xcd = wgid % NXCD, off = wgid / NXCD; wgid = (xcd < r ? xcd * (q + 1) : r * (q + 1) + (xcd - r) * q) + off; }
        const int nig = WGM * nN, gid = wgid / nig, fm = gid * WGM, gsz = (nM - fm) < WGM ? (nM - fm) : WGM;
        u.pm = fm + ((wgid % nig) % gsz); u.pn = (wgid % nig) / gsz; return true;
    }
    __device__ __forceinline__ void a_ready(const Unit&) const {}
    __device__ __forceinline__ void done(const Unit&) const {}
};

#define BPERM(v, srclane) __builtin_bit_cast(float, __builtin_amdgcn_ds_bpermute((srclane) << 2, __builtin_bit_cast(int, (float)(v))))
#define PG8_EPI_BAR() do { asm volatile("s_waitcnt lgkmcnt(0)" ::: "memory"); __builtin_amdgcn_s_barrier(); asm volatile("" ::: "memory"); } while (0)

struct EpiQKV {
    static constexpr bool PERM = true, AFTER_DRAIN = false, WANTS_NEXT = false, PERMA = false;
    bf16_t* Z; const float* gain;
    __device__ __forceinline__ void operator()(const f32x4 (&acc)[2][2][4][2], const Unit& u, int wr, int wc, int fr_in, int fq_in) const {
        int fr = fr_in, fq = fq_in; asm volatile("" : "+v"(fr), "+v"(fq));
        const int G = 4 * u.pn + wc;
        int gi; float sc = 1.f;
        if (G < 8) { gi = 0; sc = C2; } else if (G < 16) gi = 1; else if (G < 20) gi = -1; else if (G < 26) { gi = 2; sc = C2; } else if (G < 32) gi = 3;
        else if (G < 38) gi = -1; else if (G < 44) { gi = 4; sc = C2; } else if (G < 50) gi = 5; else gi = -1;
        f32x4 g[2][2];
#pragma unroll
        for (int bj = 0; bj < 2; ++bj) { g[bj][0] = (f32x4){1.f, 1.f, 1.f, 1.f}; g[bj][1] = g[bj][0]; }
        if (gi >= 0) {
#pragma unroll
            for (int bj = 0; bj < 2; ++bj) { const float* gp = gain + gi * 64 + 32 * bj + 8 * fq; g[bj][0] = *(const f32x4*)gp * sc; g[bj][1] = *(const f32x4*)(gp + 4) * sc; }
        }
        bf16_t* zb = Z + (size_t)(u.pm * BM + wr * 64 + fr) * ZP + u.pn * BM + wc * 64 + 8 * fq;
#pragma unroll
        for (int ai = 0; ai < 2; ++ai)
#pragma unroll
            for (int m = 0; m < 4; ++m) {
                float rstd = 1.f;
                if (gi >= 0) {
                    float s = 0.f;
#pragma unroll
                    for (int bj = 0; bj < 2; ++bj) { const f32x4 x0 = acc[ai][bj][m][0], x1 = acc[ai][bj][m][1];
                        s += (x0[0] * x0[0] + x0[1] * x0[1]) + (x0[2] * x0[2] + x0[3] * x0[3]) + (x1[0] * x1[0] + x1[1] * x1[1]) + (x1[2] * x1[2] + x1[3] * x1[3]); }
                    s = xor32_sum(xor16_sum(s));
                    rstd = fast_rsq(s * (1.0f / 64.0f) + EPS);
                }
#pragma unroll
                for (int bj = 0; bj < 2; ++bj) {
                    const f32x4 v0 = acc[ai][bj][m][0] * g[bj][0] * rstd, v1 = acc[ai][bj][m][1] * g[bj][1] * rstd;
                    u32x4 w; w.x = pk2(v0[0], v0[1]); w.y = pk2(v0[2], v0[3]); w.z = pk2(v1[0], v1[1]); w.w = pk2(v1[2], v1[3]);
                    *(u32x4*)(zb + (size_t)(ai * 128 + m * 16) * ZP + 32 * bj) = w;
                }
            }
    }
};

struct EpiPlain {
    static constexpr bool PERM = true, AFTER_DRAIN = false, WANTS_NEXT = false, PERMA = false;
    bf16_t* Z;
    __device__ __forceinline__ void operator()(const f32x4 (&acc)[2][2][4][2], const Unit& u, int wr, int wc, int fr_in, int fq_in) const {
        int fr = fr_in, fq = fq_in; asm volatile("" : "+v"(fr), "+v"(fq));
#pragma unroll
        for (int ai = 0; ai < 2; ++ai)
#pragma unroll
            for (int m = 0; m < 4; ++m)
#pragma unroll
                for (int bj = 0; bj < 2; ++bj) {
                    const f32x4 v0 = acc[ai][bj][m][0], v1 = acc[ai][bj][m][1];
                    u32x4 w; w.x = pk2(v0[0], v0[1]); w.y = pk2(v0[2], v0[3]); w.z = pk2(v1[0], v1[1]); w.w = pk2(v1[2], v1[3]);
                    *(u32x4*)(Z + (size_t)(u.pm * BM + ai * 128 + wr * 64 + m * 16 + fr) * ZP + u.pn * BM + bj * HALF + wc * 32 + 8 * fq) = w;
                }
    }
};

#define BF16_LO(w) __uint_as_float((w) << 16)
#define BF16_HI(w) __uint_as_float((w) & 0xffff0000u)
struct EpiResid {
    static constexpr bool PERM = true, AFTER_DRAIN = false, WANTS_NEXT = false, PERMA = false;
    const float* xbase; bf16_t* hb; u64_t* rsq;
    __device__ __forceinline__ void operator()(const f32x4 (&acc)[2][2][4][2], const Unit& u, int wr, int wc, int fr_in, int fq_in) const {
        int fr = fr_in, fq = fq_in; asm volatile("" : "+v"(fr), "+v"(fq));
#pragma unroll
        for (int ai = 0; ai < 2; ++ai)
#pragma unroll
            for (int m = 0; m < 4; ++m) {
                const int row = u.pm * BM + ai * 128 + wr * 64 + m * 16 + fr;
                float s = 0.f;
#pragma unroll
                for (int bj = 0; bj < 2; ++bj) {
                    const size_t off = (size_t)row * DM + u.pn * BM + bj * HALF + wc * 32 + 8 * fq;
                    f32x4 b0, b1;
                    if (xbase) { b0 = *(const f32x4*)(xbase + off); b1 = *(const f32x4*)(xbase + off + 4); }
                    else { const u32x4 q = *(const u32x4*)(hb + off);
                        b0 = (f32x4){BF16_LO(q.x), BF16_HI(q.x), BF16_LO(q.y), BF16_HI(q.y)}; b1 = (f32x4){BF16_LO(q.z), BF16_HI(q.z), BF16_LO(q.w), BF16_HI(q.w)}; }
                    const f32x4 h0 = b0 + acc[ai][bj][m][0], h1 = b1 + acc[ai][bj][m][1];
                    u32x4 w; w.x = pk2(h0[0], h0[1]); w.y = pk2(h0[2], h0[3]); w.z = pk2(h1[0], h1[1]); w.w = pk2(h1[2], h1[3]);
                    *(u32x4*)(hb + off) = w;
                    s += (h0[0] * h0[0] + h0[1] * h0[1]) + (h0[2] * h0[2] + h0[3] * h0[3]) + (h1[0] * h1[0] + h1[1] * h1[1]) + (h1[2] * h1[2] + h1[3] * h1[3]);
                }
                s = xor32_sum(xor16_sum(s));
                if (fq == 0) atomicAdd(rsq + row, (u64_t)(s * 16777216.0f));
                if (m == 3) asm volatile("" ::: "memory");
            }
    }
};

struct EpiSig {
    static constexpr bool PERM = true, AFTER_DRAIN = false, WANTS_NEXT = false, PERMA = false;
    bf16_t* SG; const u64_t* rsq;
    __device__ __forceinline__ void operator()(const f32x4 (&acc)[2][2][4][2], const Unit& u, int wr, int wc, int fr_in, int fq_in) const {
        int fr = fr_in, fq = fq_in; asm volatile("" : "+v"(fr), "+v"(fq));
        const int rowb = u.pm * BM + wr * 64 + fr;
        float rs[2][4];
#pragma unroll
        for (int ai = 0; ai < 2; ++ai)
#pragma unroll
            for (int m = 0; m < 4; ++m) rs[ai][m] = rsq_sum(rsq, rowb + ai * 128 + m * 16);
#pragma unroll
        for (int ai = 0; ai < 2; ++ai)
#pragma unroll
            for (int m = 0; m < 4; ++m) rs[ai][m] = fast_rsq(rs[ai][m] * (1.0f / DM) + EPS);
#pragma unroll
        for (int ai = 0; ai < 2; ++ai)
#pragma unroll
            for (int m = 0; m < 4; ++m) {
                const int row = rowb + ai * 128 + m * 16;
#pragma unroll
                for (int bj = 0; bj < 2; ++bj) {
                    const size_t off = (size_t)row * DM + u.pn * BM + bj * HALF + wc * 32 + 8 * fq;
                    const f32x4 a = acc[ai][bj][m][0] * rs[ai][m], b = acc[ai][bj][m][1] * rs[ai][m];
                    u32x4 w; w.x = pk2(sigmoidf_(a[0]), sigmoidf_(a[1])); w.y = pk2(sigmoidf_(a[2]), sigmoidf_(a[3]));
                    w.z = pk2(sigmoidf_(b[0]), sigmoidf_(b[1])); w.w = pk2(sigmoidf_(b[2]), sigmoidf_(b[3]));
                    *(u32x4*)(SG + off) = w;
                }
            }
    }
};

struct EpiMulAdd {
    static constexpr bool PERM = true, AFTER_DRAIN = false, WANTS_NEXT = false, PERMA = false;
    const bf16_t* SG; bf16_t* hb; float* outf;
    __device__ __forceinline__ void operator()(const f32x4 (&acc)[2][2][4][2], const Unit& u, int wr, int wc, int fr_in, int fq_in) const {
        int fr = fr_in, fq = fq_in; asm volatile("" : "+v"(fr), "+v"(fq));
#pragma unroll
        for (int ai = 0; ai < 2; ++ai)
#pragma unroll
            for (int m = 0; m < 4; ++m)
#pragma unroll
                for (int bj = 0; bj < 2; ++bj) {
                    const size_t off = (size_t)(u.pm * BM + ai * 128 + wr * 64 + m * 16 + fr) * DM + u.pn * BM + bj * HALF + wc * 32 + 8 * fq;
                    const u32x4 s = *(const u32x4*)(SG + off), q = *(const u32x4*)(hb + off);
                    const f32x4 s0 = {BF16_LO(s.x), BF16_HI(s.x), BF16_LO(s.y), BF16_HI(s.y)}, s1 = {BF16_LO(s.z), BF16_HI(s.z), BF16_LO(s.w), BF16_HI(s.w)};
                    const f32x4 b0 = {BF16_LO(q.x), BF16_HI(q.x), BF16_LO(q.y), BF16_HI(q.y)}, b1 = {BF16_LO(q.z), BF16_HI(q.z), BF16_LO(q.w), BF16_HI(q.w)};
                    const f32x4 h0 = b0 + acc[ai][bj][m][0] * s0, h1 = b1 + acc[ai][bj][m][1] * s1;
                    if (outf) { *(f32x4*)(outf + off) = h0; *(f32x4*)(outf + off + 4) = h1; }
                    else { u32x4 w; w.x = pk2(h0[0], h0[1]); w.y = pk2(h0[2], h0[3]); w.z = pk2(h1[0], h1[1]); w.w = pk2(h1[2], h1[3]); *(u32x4*)(hb + off) = w; }
                    if (bj == 1 && (m & 1)) asm volatile("" ::: "memory");
                }
    }
};

struct EpiUp {
    static constexpr bool PERM = false, AFTER_DRAIN = false, WANTS_NEXT = true, PERMA = true;
    bf16_t* A; const float* cw; const float* cb; float* edge; PG8_LAS float* xr; const u64_t* rsq; PG8_LAS float* prm; PG8_LAS float* rsd;
    __device__ __forceinline__ float ldp(int j, int pn) const { const int gv = j >> 9, tap = (j >> 7) & 3, col = gv * DFF + 128 * pn + (j & 127); return tap < 3 ? cw[tap * UPN + col] : cb[col]; }
#define DPPO(oldv, v, ctrl) __builtin_bit_cast(float, __builtin_amdgcn_update_dpp(__builtin_bit_cast(int, (float)(oldv)), __builtin_bit_cast(int, (float)(v)), (ctrl), 0xf, 0xf, false))
    __device__ __forceinline__ void run(const f32x4 (&acc)[2][2][4][2], const Unit& u, const Unit& nxt, bool has_next, int ui, int wr, int wc, int fr_in, int fq_in) const {
        int fr = fr_in, fq = fq_in; asm volatile("" : "+v"(fr), "+v"(fq));
        const int tid = (wr * 4 + wc) * 64 + fq * 16 + fr;
        const int slot = ui & 1;
        if (ui == 0) {
            prm[slot * 1024 + tid] = ldp(tid, u.pn); prm[slot * 1024 + tid + 512] = ldp(tid + 512, u.pn);
            if (tid < 256) rsd[slot * 256 + tid] = row_rstd(rsq, u.pm * BM + tid);
            PG8_EPI_BAR();
        }
        float nx0 = 0.f, nx1 = 0.f, nrs = 1.f;
        if (has_next) { nx0 = ldp(tid, nxt.pn); nx1 = ldp(tid + 512, nxt.pn); if (tid < 256) nrs = rsq_sum(rsq, nxt.pm * BM + tid); }
        float* eg = edge + (size_t)(u.pm * 22 + u.pn) * 1024;
        float rs[2][4];
#pragma unroll
        for (int ai = 0; ai < 2; ++ai)
#pragma unroll
            for (int m = 0; m < 4; ++m) rs[ai][m] = rsd[slot * 256 + ai * 128 + wr * 64 + 4 * fr + m];
#pragma unroll
        for (int bj = 0; bj < 2; ++bj)
#pragma unroll
            for (int n = 0; n < 2; ++n) {
                const int colt = bj * 128 + wc * 32 + n * 16 + 4 * fq;
                if (fr == 15) {
                    *(PG8_LAS f32x4*)(xr + ((0 + wr) * 2 + 0) * 256 + colt) = acc[0][bj][2][n] * rs[0][2]; *(PG8_LAS f32x4*)(xr + ((0 + wr) * 2 + 1) * 256 + colt) = acc[0][bj][3][n] * rs[0][3];
                    *(PG8_LAS f32x4*)(xr + ((2 + wr) * 2 + 0) * 256 + colt) = acc[1][bj][2][n] * rs[1][2]; *(PG8_LAS f32x4*)(xr + ((2 + wr) * 2 + 1) * 256 + colt) = acc[1][bj][3][n] * rs[1][3];
                    if (wr == 1) { *(f32x4*)(eg + 2 * 256 + colt) = acc[1][bj][2][n] * rs[1][2]; *(f32x4*)(eg + 3 * 256 + colt) = acc[1][bj][3][n] * rs[1][3]; }
                }
                if (wr == 0 && fr == 0) { *(f32x4*)(eg + colt) = acc[0][bj][0][n] * rs[0][0]; *(f32x4*)(eg + 256 + colt) = acc[0][bj][1][n] * rs[0][1]; }
            }
        PG8_EPI_BAR();
#pragma unroll
        for (int ai = 0; ai < 2; ++ai)
#pragma unroll
            for (int m = 0; m < 4; ++m) asm volatile("" : "+v"(rs[ai][m]));
#pragma unroll
        for (int n = 0; n < 2; ++n) {
            const int cl = wc * 32 + n * 16 + 4 * fq, ch = u.pn * 128 + cl;
            const PG8_LAS float* pp = prm + slot * 1024 + cl;
            const f32x4 wg0 = *(const PG8_LAS f32x4*)(pp), wg1 = *(const PG8_LAS f32x4*)(pp + 128), wg2 = *(const PG8_LAS f32x4*)(pp + 256), bg = *(const PG8_LAS f32x4*)(pp + 384);
            const f32x4 wv0 = *(const PG8_LAS f32x4*)(pp + 512), wv1 = *(const PG8_LAS f32x4*)(pp + 640), wv2 = *(const PG8_LAS f32x4*)(pp + 768), bv = *(const PG8_LAS f32x4*)(pp + 896);
#pragma unroll
            for (int ai = 0; ai < 2; ++ai) {
                const int grp = 2 * ai + wr;
                f32x4 hg2 = {0.f, 0.f, 0.f, 0.f}, hg3 = hg2, hv2 = hg2, hv3 = hg2;
                if (grp > 0 && fr == 0) { const PG8_LAS float* xp = xr + ((grp - 1) * 2) * 256 + cl;
                    hg2 = *(const PG8_LAS f32x4*)(xp); hg3 = *(const PG8_LAS f32x4*)(xp + 256); hv2 = *(const PG8_LAS f32x4*)(xp + 128); hv3 = *(const PG8_LAS f32x4*)(xp + 256 + 128); }
                f32x4 pg2, pg1, pv2, pv1;
                {
                    const f32x4 g2 = acc[ai][0][2][n] * rs[ai][2], g3 = acc[ai][0][3][n] * rs[ai][3], v2 = acc[ai][1][2][n] * rs[ai][2], v3 = acc[ai][1][3][n] * rs[ai][3];
#pragma unroll
                    for (int i = 0; i < 4; ++i) {
                        float a0 = g2[i], a1 = g3[i], a2 = v2[i], a3 = v3[i];
                        asm volatile("" : "+v"(a0), "+v"(a1), "+v"(a2), "+v"(a3));
                        const float t0 = DPPF(a0, 0x111), t1 = DPPF(a1, 0x111), t2 = DPPF(a2, 0x111), t3 = DPPF(a3, 0x111);
                        pg2[i] = t0 + hg2[i]; pg1[i] = t1 + hg3[i]; pv2[i] = t2 + hv2[i]; pv1[i] = t3 + hv3[i]; }
                }
#pragma unroll
                for (int m = 0; m < 4; ++m) {
                    const f32x4 gc = acc[ai][0][m][n] * rs[ai][m], vc = acc[ai][1][m][n] * rs[ai][m];
                    const f32x4 cgt = bg + wg0 * pg2 + wg1 * pg1 + wg2 * gc, cvl = bv + wv0 * pv2 + wv1 * pv1 + wv2 * vc;
                    float a[4];
#pragma unroll
                    for (int i = 0; i < 4; ++i) a[i] = cgt[i] * sigmoidf_(cgt[i]) * cvl[i];
                    u32x2 w; w.x = pk2(a[0], a[1]); w.y = pk2(a[2], a[3]);
                    *(u32x2*)(A + (size_t)(u.pm * BM + ai * 128 + wr * 64 + 4 * fr + m) * DFF + ch) = w;
                    pg2 = pg1; pg1 = gc; pv2 = pv1; pv1 = vc;
                }
                asm volatile("" ::: "memory");
            }
        }
        if (has_next) {
            prm[(slot ^ 1) * 1024 + tid] = nx0; prm[(slot ^ 1) * 1024 + tid + 512] = nx1;
            if (tid < 256) rsd[(slot ^ 1) * 256 + tid] = fast_rsq(nrs * (1.0f / DM) + EPS);
        }
    }
};
template <class Epi, class Sched, bool ALIGN_EPI = false, bool SP2 = false>
__device__ __forceinline__ void gemm_phase(PG8_LAS unsigned char* lds, const Gemm g, const Sched& S, const Epi& E, const int tid_arg) {
    int tid_l = tid_arg; asm volatile("" : "+v"(tid_l));
    const int tid = tid_l, wid = __builtin_amdgcn_readfirstlane(tid >> 6), lane = tid & 63, wr = wid >> 2, wc = wid & 3, fr = lane & 15, fq = lane >> 4;
    const int K = g.K, nt = K / BK;
    unsigned voffA[2], voffB[2];
#pragma unroll
    for (int i = 0; i < 2; ++i) { int R, C; stage_rc(tid * 16 + i * 8192, R, C); const int Rb = Epi::PERM ? ((R & ~31) + perm32(R & 31)) : R;
        const int Ra = Epi::PERMA ? ((R & ~63) + 4 * (R & 15) + ((R >> 4) & 3)) : R;
        voffA[i] = (unsigned)(Ra * K + C) * 2u; voffB[i] = (unsigned)(Rb * K + C) * 2u; }
    const size_t kstep = (size_t)(BK * 2);
    const size_t hstep = (size_t)HALF * K * 2;
    const size_t tstep = 2 * hstep;
    const unsigned ldsw = (unsigned)wid * 1024u;
    const int aoff = lds_byte(wr * 64 + fr, fq * 8), boff = lds_byte(wc * 32 + fr, fq * 8);
#define PG8_SA(b, h) (((b) * 2 + (h)) * HTB)
#define PG8_SB(b, h) ((4 + (b) * 2 + (h)) * HTB)
#define PG8_STAGE(bufoff, gbase, voff) do { _Pragma("unroll") for (int _i = 0; _i < 2; ++_i) \
        __builtin_amdgcn_global_load_lds((const unsigned*)((const char*)(gbase) + (voff)[_i]), (PG8_LAS unsigned*)(lds + (bufoff) + ldsw + _i * 8192), 16, 0, 0); } while (0)
#define PG8_LDA(dst, b, h) do { _Pragma("unroll") for (int m = 0; m < 4; ++m) _Pragma("unroll") for (int k = 0; k < 2; ++k) dst[m][k] = *(const PG8_LAS bf16x8*)(lds + PG8_SA(b, h) + aoff + m * 2048 + k * 1024); } while (0)
#define PG8_LDB(dst, b, h) do { _Pragma("unroll") for (int n = 0; n < 2; ++n) _Pragma("unroll") for (int k = 0; k < 2; ++k) dst[n][k] = *(const PG8_LAS bf16x8*)(lds + PG8_SB(b, h) + boff + n * 2048 + k * 1024); } while (0)
#define PG8_MMA(ai, bj, At, Bt) do { __builtin_amdgcn_s_setprio(1); _Pragma("unroll") for (int m = 0; m < 4; ++m) _Pragma("unroll") for (int n = 0; n < 2; ++n) _Pragma("unroll") for (int k = 0; k < 2; ++k) \
        acc[ai][bj][m][n] = __builtin_amdgcn_mfma_f32_16x16x32_bf16(Bt[n][k], At[m][k], acc[ai][bj][m][n], 0, 0, 0); __builtin_amdgcn_s_setprio(0); } while (0)
#define PG8_WAIT_V(n) asm volatile("s_waitcnt vmcnt(" #n ")" ::: "memory")
#define PG8_WAIT_L(n) asm volatile("s_waitcnt lgkmcnt(" #n ")" ::: "memory")
#define PG8_BAR __builtin_amdgcn_s_barrier()
#define PG8_SCHED __builtin_amdgcn_sched_barrier(0)
    Unit cur, nxt; int ui = 0;
    if (!S.next(0, cur)) return;
    f32x4 acc[2][2][4][2];
#pragma unroll
    for (int a = 0; a < 2; ++a)
#pragma unroll
        for (int b = 0; b < 2; ++b)
#pragma unroll
            for (int m = 0; m < 4; ++m)
#pragma unroll
                for (int n = 0; n < 2; ++n) acc[a][b][m][n] = (f32x4){0.f, 0.f, 0.f, 0.f};
    bf16x8 At[4][2], B0[2][2], B1[2][2];
    const char* cA = (const char*)g.A + (size_t)cur.pm * tstep; const char* cB = (const char*)g.Bt + (size_t)cur.pn * tstep;
    S.a_ready(cur);
    if constexpr (SP2) {
        PG8_STAGE(PG8_SB(0, 0), cB, voffB); PG8_STAGE(PG8_SB(0, 1), cB + hstep, voffB); PG8_STAGE(PG8_SA(0, 0), cA, voffA); PG8_STAGE(PG8_SA(0, 1), cA + hstep, voffA);
        if (wr == 1) PG8_BAR;
        PG8_WAIT_V(2); PG8_BAR;
        PG8_STAGE(PG8_SB(1, 0), cB + kstep, voffB); PG8_STAGE(PG8_SA(1, 0), cA + kstep, voffA); PG8_STAGE(PG8_SB(1, 1), cB + hstep + kstep, voffB);
        PG8_WAIT_V(6); PG8_BAR;
    } else {
        PG8_STAGE(PG8_SB(0, 0), cB, voffB); PG8_STAGE(PG8_SA(0, 0), cA, voffA); PG8_STAGE(PG8_SB(0, 1), cB + hstep, voffB); PG8_STAGE(PG8_SA(0, 1), cA + hstep, voffA);
        if (wr == 1) PG8_BAR;
        PG8_WAIT_V(4); PG8_BAR;
        PG8_STAGE(PG8_SB(1, 0), cB + kstep, voffB); PG8_STAGE(PG8_SA(1, 0), cA + kstep, voffA); PG8_STAGE(PG8_SB(1, 1), cB + hstep + kstep, voffB);
        PG8_WAIT_V(6); PG8_BAR;
    }
    for (;;) {
        const bool has_next = S.next(ui + 1, nxt);
        const char* nA = has_next ? (const char*)g.A + (size_t)nxt.pm * tstep : cA; const char* nB = has_next ? (const char*)g.Bt + (size_t)nxt.pn * tstep : cB;
        for (int t = 0; t < nt; t += 2) {
            const bool last = (t == nt - 2);
            const char* a1 = cA + (size_t)(t + 1) * kstep;
            const char* a2 = last ? nA : cA + (size_t)(t + 2) * kstep; const char* b2 = last ? nB : cB + (size_t)(t + 2) * kstep;
            const char* a3 = a2 + kstep; const char* b3 = b2 + kstep;
            if (last && has_next) S.a_ready(nxt);
            if constexpr (SP2) {
            PG8_LDB(B0, 0, 0); PG8_LDB(B1, 0, 1); PG8_SCHED; PG8_LDA(At, 0, 0); PG8_STAGE(PG8_SA(1, 1), a1 + hstep, voffA);
            PG8_WAIT_V(8); PG8_WAIT_L(0); PG8_BAR; PG8_MMA(0, 0, At, B0); PG8_MMA(0, 1, At, B1); PG8_BAR; PG8_SCHED;
            PG8_LDA(At, 0, 1); PG8_STAGE(PG8_SB(0, 0), b2, voffB); PG8_STAGE(PG8_SB(0, 1), b2 + hstep, voffB); PG8_STAGE(PG8_SA(0, 0), a2, voffA);
            PG8_WAIT_V(8); PG8_WAIT_L(0); PG8_BAR; PG8_MMA(1, 0, At, B0); PG8_MMA(1, 1, At, B1); PG8_BAR; PG8_SCHED;
            PG8_LDB(B0, 1, 0); PG8_LDB(B1, 1, 1); PG8_SCHED; PG8_LDA(At, 1, 0); PG8_STAGE(PG8_SA(0, 1), a2 + hstep, voffA);
            PG8_WAIT_V(8); PG8_WAIT_L(0); PG8_BAR; PG8_MMA(0, 0, At, B0); PG8_MMA(0, 1, At, B1); PG8_BAR; PG8_SCHED;
            PG8_LDA(At, 1, 1); PG8_STAGE(PG8_SB(1, 0), b3, voffB); PG8_STAGE(PG8_SB(1, 1), b3 + hstep, voffB); PG8_STAGE(PG8_SA(1, 0), a3, voffA);
            PG8_WAIT_V(8); PG8_WAIT_L(0); PG8_BAR; PG8_MMA(1, 0, At, B0); PG8_MMA(1, 1, At, B1); PG8_BAR; PG8_SCHED;
            } else {
            PG8_LDB(B0, 0, 0); PG8_SCHED; PG8_LDA(At, 0, 0); PG8_STAGE(PG8_SA(1, 1), a1 + hstep, voffA);
            PG8_WAIT_L(8); PG8_BAR; PG8_WAIT_L(0); PG8_MMA(0, 0, At, B0); PG8_BAR; PG8_SCHED;
            PG8_LDB(B1, 0, 1); PG8_STAGE(PG8_SB(0, 0), b2, voffB);
            PG8_BAR; PG8_WAIT_L(0); PG8_MMA(0, 1, At, B1); PG8_BAR;
            PG8_LDA(At, 0, 1); PG8_STAGE(PG8_SA(0, 0), a2, voffA);
            PG8_BAR; PG8_WAIT_L(0); PG8_MMA(1, 0, At, B0); PG8_BAR; PG8_SCHED;
            PG8_STAGE(PG8_SB(0, 1), b2 + hstep, voffB);
            PG8_WAIT_V(6); PG8_BAR; PG8_MMA(1, 1, At, B1); PG8_BAR;
            PG8_LDB(B0, 1, 0); PG8_SCHED; PG8_LDA(At, 1, 0); PG8_STAGE(PG8_SA(0, 1), a2 + hstep, voffA);
            PG8_WAIT_L(8); PG8_BAR; PG8_WAIT_L(0); PG8_MMA(0, 0, At, B0); PG8_BAR; PG8_SCHED;
            PG8_LDB(B1, 1, 1); PG8_STAGE(PG8_SB(1, 0), b3, voffB);
            PG8_BAR; PG8_WAIT_L(0); PG8_MMA(0, 1, At, B1); PG8_BAR;
            PG8_LDA(At, 1, 1); PG8_STAGE(PG8_SA(1, 0), a3, voffA);
            PG8_BAR; PG8_WAIT_L(0); PG8_MMA(1, 0, At, B0); PG8_BAR; PG8_SCHED;
            PG8_STAGE(PG8_SB(1, 1), b3 + hstep, voffB);
            PG8_WAIT_V(6); PG8_BAR; PG8_MMA(1, 1, At, B1); PG8_BAR;
            }
        }
        if constexpr (ALIGN_EPI) { if (wr == 0) PG8_BAR; }
        if constexpr (!Epi::AFTER_DRAIN) { if constexpr (Epi::WANTS_NEXT) E.run(acc, cur, nxt, has_next, ui, wr, wc, fr, fq); else E(acc, cur, wr, wc, fr, fq); S.done(cur); }
        if (!has_next) break;
#pragma unroll
        for (int a = 0; a < 2; ++a)
#pragma unroll
            for (int b = 0; b < 2; ++b)
#pragma unroll
                for (int m = 0; m < 4; ++m)
#pragma unroll
                    for (int n = 0; n < 2; ++n) acc[a][b][m][n] = (f32x4){0.f, 0.f, 0.f, 0.f};
        cur = nxt; cA = nA; cB = nB; ++ui;
        if constexpr (ALIGN_EPI) { if (wr == 1) PG8_BAR; }
    }
    PG8_WAIT_V(0);
    if constexpr (!ALIGN_EPI) { if (wr == 0) PG8_BAR; }
    PG8_BAR;
    if constexpr (Epi::AFTER_DRAIN) { E.fused(acc, cur, wr, wc, fr, fq, lds, wid, lane); S.done(cur); }
#undef PG8_SA
#undef PG8_SB
#undef PG8_STAGE
#undef PG8_LDA
#undef PG8_LDB
#undef PG8_MMA
#undef PG8_WAIT_V
#undef PG8_WAIT_L
#undef PG8_BAR
#undef PG8_SCHED
}
}
template <int MODE> __device__ __forceinline__ int srccol(int n) {
    if (MODE == 1) {
        const int ct = n & 255, lg = (n & ~255) + ((ct >> 5) & 3) * 64 + (ct >> 7) * 32 + (ct & 31);
        return lg < 2432 ? lg : lg + 6; }
    if (MODE == 2) { const int pn = n >> 8, j = n & 255; return j < 128 ? 128 * pn + j : DFF + 128 * pn + (j - 128); }
    return n;
}
template <int MODE> __device__ __forceinline__ void transpose_item(const float* W, int K, int Nsrc, int Ndst, bf16_t* WT, LAS float* scr, int item, int lane, const float* kgain = nullptr) {
    const int nblk = Ndst / 32, kb = item / nblk, nb = item % nblk, k0 = 64 * kb, n0 = 32 * nb;
    const int sc = srccol<MODE>(n0 + (lane & 31));
#pragma unroll
    for (int i = 0; i < 32; ++i) { const int kk = 2 * i + (lane >> 5); scr[kk * 33 + (lane & 31)] = W[(size_t)(k0 + kk) * Nsrc + sc] * (kgain ? kgain[k0 + kk] : 1.0f); }
    asm volatile("s_waitcnt lgkmcnt(0)" ::: "memory");
    const int c = lane & 7;
#pragma unroll
    for (int j = 0; j < 4; ++j) { const int n = (lane >> 3) + 8 * j; const LAS float* s = scr + (8 * c) * 33 + n;
        u32x4 o; o.x = pk2(s[0 * 33], s[1 * 33]); o.y = pk2(s[2 * 33], s[3 * 33]); o.z = pk2(s[4 * 33], s[5 * 33]); o.w = pk2(s[6 * 33], s[7 * 33]);
        *(u32x4*)(WT + (size_t)(n0 + n) * K + k0 + 8 * c) = o; }
    asm volatile("s_waitcnt lgkmcnt(0)" ::: "memory");
}

template <bool FG, bool BIN = false> __device__ __forceinline__ void norm_phase(const float* hin, const float* gain, bf16_t* out, const float* win, const float* fbias, float* logf, int gw, int NGW, int lane) {
    float g[16];
#pragma unroll
    for (int i = 0; i < 2; ++i) { const int c0 = 8 * (lane + 64 * i); const f32x4 a = *(const f32x4*)(gain + c0), b = *(const f32x4*)(gain + c0 + 4);
        g[8 * i + 0] = a[0]; g[8 * i + 1] = a[1]; g[8 * i + 2] = a[2]; g[8 * i + 3] = a[3]; g[8 * i + 4] = b[0]; g[8 * i + 5] = b[1]; g[8 * i + 6] = b[2]; g[8 * i + 7] = b[3]; }
    float wf[6][16]; float fb[6];
    if (FG) {
#pragma unroll
        for (int i = 0; i < 2; ++i)
#pragma unroll
            for (int e = 0; e < 8; ++e) { const float* wp = win + (size_t)(8 * (lane + 64 * i) + e) * INC + 2432;
#pragma unroll
                for (int j = 0; j < 6; ++j) wf[j][8 * i + e] = wp[j] * g[8 * i + e]; }
#pragma unroll
        for (int j = 0; j < 6; ++j) fb[j] = fbias[j];
    }
    f32x4 nx[4];
    const bf16_t* hbin = (const bf16_t*)hin;
#define NORM_LD(rowi) do { _Pragma("unroll") for (int i = 0; i < 2; ++i) { const int c0 = 8 * (lane + 64 * i); \
        if (BIN) { const u32x4 q_ = *(const u32x4*)(hbin + (size_t)(rowi) * DM + c0); \
            nx[2 * i] = (f32x4){__uint_as_float(q_.x << 16), __uint_as_float(q_.x & 0xffff0000u), __uint_as_float(q_.y << 16), __uint_as_float(q_.y & 0xffff0000u)}; \
            nx[2 * i + 1] = (f32x4){__uint_as_float(q_.z << 16), __uint_as_float(q_.z & 0xffff0000u), __uint_as_float(q_.w << 16), __uint_as_float(q_.w & 0xffff0000u)}; } \
        else { nx[2 * i] = *(const f32x4*)(hin + (size_t)(rowi) * DM + c0); nx[2 * i + 1] = *(const f32x4*)(hin + (size_t)(rowi) * DM + c0 + 4); } } } while (0)
    if (gw < T) NORM_LD(gw);
    for (int row = gw; row < T; row += NGW) {
        float x[16];
#pragma unroll
        for (int i = 0; i < 4; ++i) { x[4 * i + 0] = nx[i][0]; x[4 * i + 1] = nx[i][1]; x[4 * i + 2] = nx[i][2]; x[4 * i + 3] = nx[i][3]; }
        if (row + NGW < T) NORM_LD(row + NGW);
        float ss = 0.f;
#pragma unroll
        for (int e = 0; e < 16; ++e) ss += x[e] * x[e];
        ss = wave_sum(ss);
        const float rstd = fast_rsq(ss * (1.0f / DM) + EPS);
#pragma unroll
        for (int i = 0; i < 2; ++i) { u32x4 w;
            w.x = pk2(x[8 * i + 0] * rstd * g[8 * i + 0], x[8 * i + 1] * rstd * g[8 * i + 1]); w.y = pk2(x[8 * i + 2] * rstd * g[8 * i + 2], x[8 * i + 3] * rstd * g[8 * i + 3]);
            w.z = pk2(x[8 * i + 4] * rstd * g[8 * i + 4], x[8 * i + 5] * rstd * g[8 * i + 5]); w.w = pk2(x[8 * i + 6] * rstd * g[8 * i + 6], x[8 * i + 7] * rstd * g[8 * i + 7]);
            *(u32x4*)(out + (size_t)row * DM + 8 * (lane + 64 * i)) = w; }
        if (FG) {
            float mine = 0.f;
#pragma unroll
            for (int j = 0; j < 6; ++j) { float d = 0.f;
#pragma unroll
                for (int e = 0; e < 16; ++e) d += x[e] * wf[j][e];
                d = wave_sum(d) * rstd + fb[j];
                if (lane == j) mine = d; }
            if (lane < 6) { const float v = mine; logf[(size_t)row * 6 + lane] = fminf(v, 0.f) - log1pf(expf(-fabsf(v))); }
        }
    }
}

__device__ __forceinline__ void scan_unit(const float* logf, float* F2, int bh, LAS double* sd, int tid) {
    const int b = bh / 6, h = bh % 6;
    const float* src = logf + (size_t)b * SEQ * 6 + h;
    double loc[8]; double run = 0.0;
#pragma unroll
    for (int i = 0; i < 8; ++i) { run += (double)src[(size_t)(8 * tid + i) * 6]; loc[i] = run; }
    sd[tid] = run;
    __syncthreads();
    if (tid < 64) {
        double v[8], tot = 0.0;
#pragma unroll
        for (int k = 0; k < 8; ++k) { v[k] = tot; tot += sd[8 * tid + k]; }
        double inc = tot;
#pragma unroll
        for (int o = 1; o < 64; o <<= 1) {
            const int src = (tid >= o) ? tid - o : tid;
            const unsigned long long u_ = __builtin_bit_cast(unsigned long long, inc);
            const unsigned lo_ = (unsigned)__builtin_amdgcn_ds_bpermute(src << 2, (int)(unsigned)u_), hi_ = (unsigned)__builtin_amdgcn_ds_bpermute(src << 2, (int)(unsigned)(u_ >> 32));
            const double up = __builtin_bit_cast(double, ((unsigned long long)hi_ << 32) | lo_);
            if (tid >= o) inc += up;
        }
        const double base = inc - tot;
#pragma unroll
        for (int k = 0; k < 8; ++k) sd[8 * tid + k] = base + v[k];
    }
    __syncthreads();
    const double off = sd[tid];
#pragma unroll
    for (int i = 0; i < 8; ++i) F2[(size_t)bh * SEQ + 8 * tid + i] = (float)((off + loc[i]) * 1.4426950408889634);
    __syncthreads();
}

__device__ __forceinline__ void fix_rows(bf16_t* A, const float* edge, const float* cw, const float* cb, int pm, int tid) {
    const bool hasprev = (pm & 15) != 0;
#pragma unroll
    for (int it_ = 0; it_ < 6; ++it_) {
        const int ch = tid + 512 * it_; if (ch >= DFF) break;
        const int pn = ch >> 7, ci = ch & 127;
        const float* E = edge + (size_t)(pm * 22 + pn) * 1024;
        const float* P = hasprev ? edge + (size_t)((pm - 1) * 22 + pn) * 1024 : E;
        float c0[2], c1[2];
#pragma unroll
        for (int gv = 0; gv < 2; ++gv) {
            const int col = gv * 128 + ci, cc = gv * DFF + ch;
            const float u0 = E[col], u1 = E[256 + col], p254 = hasprev ? P[512 + col] : 0.f, p255 = hasprev ? P[768 + col] : 0.f;
            const float w0 = cw[cc], w1 = cw[UPN + cc], w2 = cw[2 * UPN + cc], bb = cb[cc];
            c0[gv] = bb + w0 * p254 + w1 * p255 + w2 * u0; c1[gv] = bb + w0 * p255 + w1 * u0 + w2 * u1;
        }
        const float a0 = c0[0] * sigmoidf_(c0[0]) * c0[1], a1 = c1[0] * sigmoidf_(c1[0]) * c1[1];
        A[(size_t)(pm * 256) * DFF + ch] = (bf16_t)(pk2(a0, 0.f) & 0xffffu);
        A[(size_t)(pm * 256 + 1) * DFF + ch] = (bf16_t)(pk2(a1, 0.f) & 0xffffu);
    }
}

struct AttnCtx { const bf16_t* Z; bf16_t* O; const float* F2; const float* rel; const float* subln; float lam, oml, Mb0, Mb1, Mb2; };
__device__ __forceinline__ int crow(int r, int hi) { return (r & 3) + 8 * (r >> 2) + 4 * hi; }
#define MFMA32(a, b, c) __builtin_amdgcn_mfma_f32_32x32x16_bf16((a), (b), (c), 0, 0, 0)
typedef short v4i16_t __attribute__((ext_vector_type(4)));
__device__ __forceinline__ s16x4 vtr(const LAS unsigned char* p) { return __builtin_bit_cast(s16x4, __builtin_amdgcn_ds_read_tr16_b64_v4i16((LAS v4i16_t*)p)); }

constexpr int AL_K = 0, AL_V = 32768, AL_F = 65536, AL_REL = 66560, AL_WS = 68608, AL_U = 69632;

template <int TYPE> __device__ __forceinline__ void attn_unit(const AttnCtx& C, int b, int h, int qb, LAS unsigned char* lds, int tid_in, unsigned* counter) {
    int tid = tid_in; asm volatile("" : "+v"(tid));
    const int lane = tid & 63, w = __builtin_amdgcn_readfirstlane(tid >> 6), r32 = lane & 31, hi = lane >> 5;
    const int cq = 4 * qb + (w >> 1);
    const float sl2 = (TYPE == 0) ? exp2f(-2.0f * (float)(h + 1)) * LOG2E : 0.f;
    const float dmax = (TYPE == 0) ? (160.0f + C.Mb0) / sl2 : 0.f;
    int t0 = 0; const int t1 = 4 * qb + 4;
    if (TYPE == 2) t0 = (4 * qb - 8 > 0) ? 4 * qb - 8 : 0;
    if (TYPE == 0) { const float num = (float)(256 * qb - 63) - dmax; if (num >= 0.f) t0 = (int)(num * (1.0f / 64.0f)) + 1; }
    int tfirst = 0;
    if (TYPE == 1) {
        const float* f2t = C.F2 + (size_t)(b * 6 + h) * SEQ;
        const float fend = f2t[64 * lane + 63];
        const float fq_unit = f2t[256 * qb], fq_wave = f2t[256 * qb + 32 * w];
        const unsigned long long need_u = __ballot(fq_unit - fend > -160.0f), need_w = __ballot(fq_wave - fend > -160.0f);
        t0 = need_u ? (int)__builtin_ctzll(need_u) : 0; tfirst = need_w ? (int)__builtin_ctzll(need_w) : 0;
        if (t0 > 4 * qb) t0 = 4 * qb;
    }
    t0 &= ~1;
    const int sq = 256 * qb + 32 * w + r32;
    const size_t rowb = (size_t)b * SEQ;
    LAS unsigned char* Kb = lds + AL_K; LAS unsigned char* Vb = lds + AL_V;
    LAS float* Fb = (LAS float*)(lds + AL_F); LAS float* relb = (LAS float*)(lds + AL_REL); LAS float* wscr = (LAS float*)(lds + AL_WS) + w * 32;
    constexpr int NPASS = (TYPE == 0) ? 2 : 1;
    unsigned nclaim = 0u;
    const float Mb = (TYPE == 0) ? C.Mb0 : (TYPE == 1) ? C.Mb1 : C.Mb2;
    const int kwoff = w * 1024 + lane * 16, vwoff = ((tid & 7) >> 2) * 4096 + (tid >> 3) * 64 + (tid & 3) * 16;
    const int vb0 = ((lane >> 4) & 1) * 32 + (lane & 3) * 8 + (4 * hi + ((lane & 15) >> 2)) * 64;
    f32x16 o[2], o1[2];
    if (TYPE == 2) { for (int i = tid; i < 257; i += 512) relb[i] = C.rel[h * 257 + i] * LOG2E; }
#pragma unroll
    for (int pass = 0; pass < NPASS; ++pass) {
        int qcol, kcol, vcol;
        if (TYPE == 0) { qcol = pass * 256 + 64 * h; kcol = 512 + pass * 256 + 64 * h; vcol = 1024 + 64 * h; }
        else if (TYPE == 1) { qcol = 1280 + 64 * h; kcol = 1664 + 64 * h; vcol = 2048 + 64 * h; }
        else { qcol = 2432 + 64 * h; kcol = 2816 + 64 * h; vcol = 3200 + 64 * h; }
        const bf16_t* Qp = C.Z + (rowb + sq) * ZP + qcol + 8 * hi;
        bf16x8 qr[4];
#pragma unroll
        for (int d0 = 0; d0 < 4; ++d0) qr[d0] = *(const bf16x8*)(Qp + 16 * d0);
        float cinit = -Mb;
        const float* f2p = C.F2 + (size_t)(b * 6 + h) * SEQ;
        if (TYPE == 1) cinit += f2p[sq];
        f32x16 cvec, zvec;
#pragma unroll
        for (int r = 0; r < 16; ++r) { cvec[r] = cinit; zvec[r] = 0.f; }
#pragma unroll
        for (int r = 0; r < 16; ++r) { o[0][r] = 0.f; o[1][r] = 0.f; }
        float lsum = 0.f;
        const bf16_t* kg = C.Z + (rowb + lane) * ZP + kcol + 8 * w;
        const bf16_t* vg = C.Z + (rowb + (tid >> 3)) * ZP + vcol + 8 * (tid & 7);
        u32x4 kreg = *(const u32x4*)(kg + (size_t)t0 * 64 * ZP), vreg = *(const u32x4*)(vg + (size_t)t0 * 64 * ZP);
        u32x4 kreg2 = *(const u32x4*)(kg + (size_t)(t0 + 1) * 64 * ZP), vreg2 = *(const u32x4*)(vg + (size_t)(t0 + 1) * 64 * ZP);
        float freg = 0.f, freg2 = 0.f;
        if (TYPE == 1 && tid < 64) { freg = f2p[t0 * 64 + tid]; freg2 = f2p[(t0 + 1) * 64 + tid]; }
        __syncthreads();
        for (int t = t0; t < t1; ++t) {
            const int bo = (t & 3) * 8192;
            if ((t & 1) == 0) {
                const int bo1 = ((t + 1) & 3) * 8192;
                *(LAS u32x4*)(Kb + bo + kwoff) = kreg; *(LAS u32x4*)(Vb + bo + vwoff) = vreg;
                *(LAS u32x4*)(Kb + bo1 + kwoff) = kreg2; *(LAS u32x4*)(Vb + bo1 + vwoff) = vreg2;
                if (TYPE == 1 && tid < 64) { Fb[(t & 3) * 64 + tid] = freg; Fb[((t + 1) & 3) * 64 + tid] = freg2; }
                if (t + 2 < t1) {
                    kreg = *(const u32x4*)(kg + (size_t)(t + 2) * 64 * ZP); vreg = *(const u32x4*)(vg + (size_t)(t + 2) * 64 * ZP);
                    kreg2 = *(const u32x4*)(kg + (size_t)(t + 3) * 64 * ZP); vreg2 = *(const u32x4*)(vg + (size_t)(t + 3) * 64 * ZP);
                    if (TYPE == 1 && tid < 64) { freg = f2p[(t + 2) * 64 + tid]; freg2 = f2p[(t + 3) * 64 + tid]; }
                }
                if (pass == NPASS - 1 && t + 2 >= t1 && tid == 0) nclaim = atomicAdd(counter, 1u);
                __syncthreads();
            }
            const bool active = (TYPE == 2) ? (t >= cq - 8 && t <= cq) : (TYPE == 0) ? (t <= cq && (float)(256 * qb + 32 * w - 64 * t - 63) < dmax) : (t <= cq && t >= tfirst);
            if (active) {
                f32x16 p0, p1;
                const LAS unsigned char* kp = Kb + bo + hi * 1024 + r32 * 16;
#pragma unroll
                for (int d0 = 0; d0 < 4; ++d0) {
                    const bf16x8 a0 = *(const LAS bf16x8*)(kp + d0 * 2048), a1 = *(const LAS bf16x8*)(kp + d0 * 2048 + 512);
                    if (d0 == 0) { p0 = MFMA32(a0, qr[0], (TYPE == 1 ? cvec : zvec)); p1 = MFMA32(a1, qr[0], (TYPE == 1 ? cvec : zvec)); }
                    else { p0 = MFMA32(a0, qr[d0], p0); p1 = MFMA32(a1, qr[d0], p1); }
                }
                const int xi = sq - 64 * t - 4 * hi;
                if (TYPE == 0) {
                    const float xf = (float)xi;
#pragma unroll
                    for (int r = 0; r < 16; ++r) { const float c = (float)((r & 3) + 8 * (r >> 2));
                        p0[r] = fast_exp2(p0[r] - sl2 * fabsf(xf - c)); p1[r] = fast_exp2(p1[r] - sl2 * fabsf(xf - (c + 32.f))); }
                } else if (TYPE == 1) {
                    const LAS float* fp = Fb + (t & 3) * 64 + 4 * hi;
#pragma unroll
                    for (int g = 0; g < 4; ++g) { const f32x4 fa = *(const LAS f32x4*)(fp + 8 * g), fb2 = *(const LAS f32x4*)(fp + 32 + 8 * g);
#pragma unroll
                        for (int i = 0; i < 4; i += 2) {
                            const f32x2_t d0_ = (f32x2_t){p0[4 * g + i], p0[4 * g + i + 1]} - (f32x2_t){fa[i], fa[i + 1]}, d1_ = (f32x2_t){p1[4 * g + i], p1[4 * g + i + 1]} - (f32x2_t){fb2[i], fb2[i + 1]};
                            p0[4 * g + i] = fast_exp2(d0_[0]); p0[4 * g + i + 1] = fast_exp2(d0_[1]); p1[4 * g + i] = fast_exp2(d1_[0]); p1[4 * g + i + 1] = fast_exp2(d1_[1]); } }
                    if (t == cq) { const int qrel = 32 * (w & 1) + r32;
#pragma unroll
                        for (int r = 0; r < 16; ++r) { const int kv = crow(r, hi); if (kv > qrel) p0[r] = 0.f; if (kv + 32 > qrel) p1[r] = 0.f; } }
                } else {
                    if (cq - t >= 3) { const float bc = relb[256];
#pragma unroll
                        for (int r = 0; r < 16; ++r) { p0[r] = fast_exp2(p0[r] + bc); p1[r] = fast_exp2(p1[r] + bc); }
                    } else {
#pragma unroll
                        for (int r = 0; r < 16; ++r) { const int c = (r & 3) + 8 * (r >> 2);
                            int i0 = xi - c; i0 = i0 < -128 ? -128 : (i0 > 128 ? 128 : i0); int i1 = xi - c - 32; i1 = i1 < -128 ? -128 : (i1 > 128 ? 128 : i1);
                            p0[r] = fast_exp2(p0[r] + relb[i0 + 128]); p1[r] = fast_exp2(p1[r] + relb[i1 + 128]); }
                    }
                }
                f32x2_t a2 = {0.f, 0.f};
#pragma unroll
                for (int r = 0; r < 16; r += 2) { a2 += (f32x2_t){p0[r], p0[r + 1]}; a2 += (f32x2_t){p1[r], p1[r + 1]}; }
                lsum += a2[0] + a2[1];
                bf16x8 pa[4];
#pragma unroll
                for (int s = 0; s < 2; ++s) {
                    u32x4 a, c2;
                    a.x = pk2(p0[8 * s + 0], p0[8 * s + 1]); a.y = pk2(p0[8 * s + 2], p0[8 * s + 3]); a.z = pk2(p0[8 * s + 4], p0[8 * s + 5]); a.w = pk2(p0[8 * s + 6], p0[8 * s + 7]);
                    c2.x = pk2(p1[8 * s + 0], p1[8 * s + 1]); c2.y = pk2(p1[8 * s + 2], p1[8 * s + 3]); c2.z = pk2(p1[8 * s + 4], p1[8 * s + 5]); c2.w = pk2(p1[8 * s + 6], p1[8 * s + 7]);
                    pa[s] = __builtin_bit_cast(bf16x8, a); pa[2 + s] = __builtin_bit_cast(bf16x8, c2);
                }
                const LAS unsigned char* vp = Vb + bo + vb0;
#pragma unroll
                for (int dh = 0; dh < 2; ++dh)
#pragma unroll
                    for (int ks = 0; ks < 4; ++ks) {
                        const s16x4 lo = vtr(vp + dh * 4096 + ks * 1024), hh = vtr(vp + dh * 4096 + ks * 1024 + 512);
                        const bf16x8 vf = {lo[0], lo[1], lo[2], lo[3], hh[0], hh[1], hh[2], hh[3]};
                        o[dh] = MFMA32(pa[ks], vf, o[dh]);
                    }
            }
        }
        const float ltot = xor32_sum(lsum);
        if (hi == 0) wscr[r32] = 1.0f / ltot;
#pragma unroll
        for (int g = 0; g < 4; ++g) { const f32x4 iv = *(const LAS f32x4*)(wscr + 8 * g + 4 * hi);
#pragma unroll
            for (int i = 0; i < 4; ++i) { o[0][4 * g + i] *= iv[i]; o[1][4 * g + i] *= iv[i]; } }
        if (TYPE == 0) {
            if (pass == 0) { o1[0] = o[0]; o1[1] = o[1]; }
            else {
#pragma unroll
                for (int r = 0; r < 16; ++r) { o[0][r] = o1[0][r] - C.lam * o[0][r]; o[1][r] = o1[1][r] - C.lam * o[1][r]; }
            }
        }
    }
    int ocol;
    if (TYPE == 0) {
        ocol = 64 * h;
        const float g0 = C.subln[r32], g1 = C.subln[32 + r32];
#pragma unroll
        for (int r = 0; r < 16; ++r) {
            float ss = o[0][r] * o[0][r] + o[1][r] * o[1][r];
            ss = xor16_sum(row16_sum(ss));
            const float rs = C.oml * fast_rsq(ss * (1.0f / 64.0f) + EPS);
            o[0][r] *= rs * g0; o[1][r] *= rs * g1;
        }
    } else if (TYPE == 1) ocol = 256 + 64 * h; else ocol = 640 + 64 * h;
    bf16_t* Op = C.O + (rowb + 256 * qb + 32 * w) * DM + ocol + r32;
#pragma unroll
    for (int r = 0; r < 16; ++r) {
        const size_t ro = (size_t)crow(r, hi) * DM;
        Op[ro] = (bf16_t)(pk2(o[0][r], 0.f) & 0xffffu); Op[ro + 32] = (bf16_t)(pk2(o[1][r], 0.f) & 0xffffu);
    }
    if (tid == 0) ((LAS unsigned*)(lds + AL_U))[0] = nclaim;
}

constexpr int ATT_UNITS = 2048;
__device__ __forceinline__ void attn_phase(const AttnCtx& C, unsigned* counter, LAS unsigned char* lds, int tid) {
    LAS unsigned* ub = (LAS unsigned*)(lds + AL_U);
    __syncthreads();
    if (tid == 0) ub[0] = atomicAdd(counter, 1u);
    for (;;) {
        __syncthreads();
        const int u = (int)ub[0];
        if (u >= ATT_UNITS) break;
        int ty, ub_, uh, uq;
        if (u < 256) { ty = 0; ub_ = (u & 31) >> 2; uh = u & 3; uq = 15 - (u >> 5); }
        else if (u < 1280) { const int v = u - 256, q = 7 - (v >> 7), wv = v & 127;
            if (wv < 32) { ty = 0; ub_ = wv >> 2; uh = wv & 3; uq = q; }
            else if (wv < 80) { ty = 1; ub_ = (wv - 32) / 6; uh = (wv - 32) % 6; uq = 2 * q + 1; }
            else { ty = 1; ub_ = (wv - 80) / 6; uh = (wv - 80) % 6; uq = 2 * q; } }
        else { const int v = u - 1280; ty = 2; ub_ = (v % 48) / 6; uh = (v % 48) % 6; uq = 15 - v / 48; }
        if (ty == 0) attn_unit<0>(C, ub_, uh, uq, lds, tid, counter);
        else if (ty == 1) attn_unit<1>(C, ub_, uh, uq, lds, tid, counter);
        else attn_unit<2>(C, ub_, uh, uq, lds, tid, counter);
    }
}
struct Args { const float* in[18]; float* out; unsigned char* ws; };
constexpr int LDS_TOTAL = 149760, LDS_XCH = 131072, LDS_PRM = LDS_XCH + 8256, LDS_RSD = LDS_PRM + 8192;
#ifdef PROBE_SYNC2
#define GSYNC() do { xcd_barrier(xbar, K_TID == 0); xcd_barrier(xbar, K_TID == 0); } while (0)
#else
#define GSYNC() xcd_barrier(xbar, K_TID == 0)
#endif
__device__ __forceinline__ int lane_fresh() { unsigned m = ~0u; asm volatile("" : "+s"(m)); int t = (int)__builtin_amdgcn_mbcnt_hi(m, __builtin_amdgcn_mbcnt_lo(m, 0u)); asm volatile("" : "+v"(t)); return t; }
typedef const __attribute__((address_space(4))) Args* kargs_t;
__device__ __forceinline__ kargs_t kargs() { kargs_t p = (kargs_t)__builtin_amdgcn_kernarg_segment_ptr(); asm volatile("" : "+s"(p)); return p; }
#define AIN(i) (kargs()->in[i])
#define AOUT (kargs()->out)
#define AWS (kargs()->ws)
#define P_HN ((bf16_t*)(AWS + WS_HN))
#define P_Zb ((bf16_t*)(AWS + WS_Z))
#define P_LOGF ((float*)(AWS + WS_LOGF))
#define P_F2 ((float*)(AWS + WS_F2))
#define P_EDGE ((float*)(AWS + WS_EDGE))
#define P_PB ((bf16_t*)(AWS + WS_PB))
#define P_HB ((bf16_t*)(AWS + WS_HB))
#define P_RSQ ((u64_t*)(AWS + WS_RSQ))

__global__ void __launch_bounds__(512, 2) fwd_megakernel(Args a) {
    __shared__ __attribute__((aligned(16))) unsigned char lds_raw[LDS_TOTAL];
    cg::grid_group grid = cg::this_grid();
    LAS unsigned char* lds = (LAS unsigned char*)lds_raw;
    const int G = gridDim.x, bx = blockIdx.x, NGW = G * 8;
    const int wave_s = __builtin_amdgcn_readfirstlane((int)threadIdx.x >> 6);
#define K_TID ((wave_s << 6) | lane_fresh())
#define K_LANE (lane_fresh())
#define K_WAVE (wave_s)
#define K_GW (bx * 8 + K_WAVE)
    volatile LAS unsigned* xst = (volatile LAS unsigned*)(lds + LDS_XCH + 8192);
    if (K_TID < 4) xst[K_TID] = 0u;
    __syncthreads();
    XcdBarrier xbar = xcd_barrier_post((unsigned*)(AWS + WS_CTL), xst);
#ifdef PROBE_P0X2
    for (int rep_ = 0; rep_ < 2; ++rep_)
#endif
    {
        LAS float* scr = (LAS float*)(lds + K_WAVE * 8448);
        constexpr int I_IN = 16 * 112, I_OUT = 16 * 32, I_UP = 16 * 176, I_DN = 44 * 32, I_GT = 16 * 32, I_PJ = 4 * 32, I_L = I_IN + I_OUT + I_UP + I_DN + I_GT + I_PJ;
        for (int it = K_GW; it < 2 * I_L; it += NGW) {
            const int l = it / I_L; int r = it % I_L;
            if (r < I_IN) { transpose_item<1>(AIN(3) + (size_t)l * DM * INC, DM, INC, ZP, (bf16_t*)(AWS + WS_WIN + l * SZ_WIN), scr, r, K_LANE); continue; } r -= I_IN;
            if (r < I_OUT) { transpose_item<0>(AIN(9) + (size_t)l * DM * DM, DM, DM, DM, (bf16_t*)(AWS + WS_WOUT + l * SZ_WOUT), scr, r, K_LANE); continue; } r -= I_OUT;
            if (r < I_UP) { transpose_item<2>(AIN(11) + (size_t)l * DM * UPN, DM, UPN, UPN, (bf16_t*)(AWS + WS_WUP + l * SZ_WUP), scr, r, K_LANE, AIN(10) + l * DM); continue; } r -= I_UP;
            if (r < I_DN) { transpose_item<0>(AIN(14) + (size_t)l * DFF * DM, DFF, DM, DM, (bf16_t*)(AWS + WS_WDN + l * SZ_WDN), scr, r, K_LANE); continue; } r -= I_DN;
            if (r < I_GT) { transpose_item<0>(AIN(16) + (size_t)l * DM * DM, DM, DM, DM, (bf16_t*)(AWS + WS_WGT + l * SZ_WGT), scr, r, K_LANE, AIN(15) + l * DM); continue; } r -= I_GT;
            transpose_item<0>(AIN(17) + (size_t)l * PLED * DM, PLED, DM, DM, (bf16_t*)(AWS + WS_WPJ + l * SZ_WPJ), scr, r, K_LANE);
        }
        { unsigned* rq = (unsigned*)P_RSQ; for (int i = bx * 512 + K_TID; i < 8 * T; i += G * 512) rq[i] = 0u; }
        const size_t n8 = (size_t)2 * T * PLED / 8; const float* pp_ = AIN(1); bf16_t* pb_ = P_PB;
        for (size_t i = (size_t)bx * 512 + K_TID; i < n8; i += (size_t)G * 512) {
            const f32x4 v0 = *(const f32x4*)(pp_ + 8 * i), v1 = *(const f32x4*)(pp_ + 8 * i + 4);
            u32x4 w; w.x = pk2(v0[0], v0[1]); w.y = pk2(v0[2], v0[3]); w.z = pk2(v1[0], v1[1]); w.w = pk2(v1[2], v1[3]);
            *(u32x4*)(pb_ + 8 * i) = w;
        }
    }

    auto layer = [&](const int l) __attribute__((always_inline)) {

        {
#ifndef SKIP_NORMFG
            int lane_l = K_LANE, gw_l = K_GW; asm volatile("" : "+v"(lane_l), "+s"(gw_l));
#ifdef PROBE_P0X2
            for (int rep_ = 0; rep_ < 2; ++rep_)
#endif
            if (l == 0) norm_phase<true, false>(AIN(0), AIN(2) + l * DM, P_HN, AIN(3) + (size_t)l * DM * INC, AIN(7) + l * 6, P_LOGF, gw_l, NGW, lane_l);
            else norm_phase<true, true>((const float*)P_HB, AIN(2) + l * DM, P_HN, AIN(3) + (size_t)l * DM * INC, AIN(7) + l * 6, P_LOGF, gw_l, NGW, lane_l);
#endif
            if (l == 0 && gridDim.x > 1000000u) grid.sync();
            GSYNC();
        }
        {
#ifndef SKIP_SCAN
            if (bx < 48) { int tid_l = K_TID, bh_l = bx; asm volatile("" : "+v"(tid_l), "+s"(bh_l)); scan_unit(P_LOGF, P_F2, bh_l, (LAS double*)lds, tid_l); }
#endif
#ifndef SKIP_QKV
            pg8::Gemm g{P_HN, (const bf16_t*)(AWS + WS_WIN + l * SZ_WIN), T, ZP, DM}; pg8::StaticOrder S; S.init(T, ZP, G, bx);
            pg8::EpiQKV E{P_Zb, AIN(4) + l * 6 * 64};
#ifdef PROBE_PLAINQKV
            { pg8::EpiPlain EP{P_Zb}; pg8::gemm_phase<pg8::EpiPlain, pg8::StaticOrder, true, true>(lds, g, S, EP, K_TID); }
#endif
            pg8::gemm_phase<pg8::EpiQKV, pg8::StaticOrder, true, true>(lds, g, S, E, K_TID);
#ifdef PROBE_QKV2
            pg8::gemm_phase<pg8::EpiQKV, pg8::StaticOrder, true, true>(lds, g, S, E, K_TID);
#endif
#endif
        }
        GSYNC();
        {
            int lane_l = K_LANE, tid_l = K_TID; asm volatile("" : "+v"(lane_l), "+v"(tid_l));
            const float* gq = AIN(4) + l * 6 * 64;
            float mg[6];
#pragma unroll
            for (int j = 0; j < 6; ++j) mg[j] = wave_max(fabsf(gq[j * 64 + lane_l]));
            const float* rel = AIN(8) + l * 6 * 257;
            float mr = 0.f;
            for (int i = lane_l; i < 6 * 257; i += 64) mr = fmaxf(mr, fabsf(rel[i]));
            mr = wave_max(mr);
            const float* lp = AIN(5) + l * 4 * 64;
            const float s01 = wave_sum(lp[lane_l] * lp[64 + lane_l]), s23 = wave_sum(lp[128 + lane_l] * lp[192 + lane_l]);
            const float lam_init = (l == 0) ? 0.2f : (0.8f - 0.6f * 0.7408182206817179f);
            AttnCtx C;
            C.Z = P_Zb; C.O = P_HN; C.F2 = P_F2; C.rel = rel; C.subln = AIN(6) + l * 64;
            C.lam = expf(s01) - expf(s23) + lam_init; C.oml = 1.0f - lam_init;
            C.Mb0 = 8.0f * mg[0] * mg[1] * LOG2E * 1.02f + 1.0f; C.Mb1 = 8.0f * mg[2] * mg[3] * LOG2E * 1.02f + 1.0f; C.Mb2 = 8.0f * mg[4] * mg[5] * LOG2E * 1.02f + 1.0f + mr * LOG2E;
#ifndef SKIP_ATTN
            #define RFL(x) __uint_as_float(__builtin_amdgcn_readfirstlane(__float_as_uint(x)))
            C.lam = RFL(C.lam); C.oml = RFL(C.oml); C.Mb0 = RFL(C.Mb0); C.Mb1 = RFL(C.Mb1); C.Mb2 = RFL(C.Mb2);
            attn_phase(C, (unsigned*)(AWS + WS_CTL) + CTL_Q + 16 * (1 + l), lds, tid_l);
#ifdef PROBE_ATTN2
            attn_phase(C, (unsigned*)(AWS + WS_CTL) + CTL_Q + 16 * (1 + l) + 8, lds, tid_l);
#endif
#endif
        }
        GSYNC();
        {
            pg8::Gemm g{P_HN, (const bf16_t*)(AWS + WS_WOUT + l * SZ_WOUT), T, DM, DM}; pg8::StaticOrder S; S.init(T, DM, G, bx);
            pg8::EpiResid E{(l == 0) ? AIN(0) : (const float*)nullptr, P_HB, P_RSQ + (size_t)(2 * l) * T};
            pg8::gemm_phase<pg8::EpiResid, pg8::StaticOrder, true, true>(lds, g, S, E, K_TID);
        }
        GSYNC();
        {
            pg8::Gemm g{P_HB, (const bf16_t*)(AWS + WS_WUP + l * SZ_WUP), T, UPN, DM}; pg8::StaticOrder S; S.init(T, UPN, G, bx);
            pg8::EpiUp E{P_Zb, AIN(12) + (size_t)l * 3 * UPN, AIN(13) + l * UPN, P_EDGE, (LAS float*)(lds + LDS_XCH), P_RSQ + (size_t)(2 * l) * T, (LAS float*)(lds + LDS_PRM), (LAS float*)(lds + LDS_RSD)};
#ifndef SKIP_UP
            pg8::gemm_phase<pg8::EpiUp, pg8::StaticOrder, true, true>(lds, g, S, E, K_TID);
#ifdef PROBE_UP2
            pg8::gemm_phase<pg8::EpiUp, pg8::StaticOrder, true, true>(lds, g, S, E, K_TID);
#endif
#endif
        }
        GSYNC();
        {
            pg8::Gemm g{P_Zb, (const bf16_t*)(AWS + WS_WDN + l * SZ_WDN), T, DM, DFF}; pg8::StaticOrder S; S.init(T, DM, G, bx);
            pg8::Unit u;
            int tid_l = K_TID; asm volatile("" : "+v"(tid_l));
            for (int i = 0; S.next(i, u); ++i) fix_rows(P_Zb, P_EDGE, AIN(12) + (size_t)l * 3 * UPN, AIN(13) + l * UPN, u.pm, tid_l);
            asm volatile("s_waitcnt vmcnt(0)" ::: "memory");
            __syncthreads();
            pg8::EpiResid E{nullptr, P_HB, P_RSQ + (size_t)(2 * l + 1) * T};
            pg8::gemm_phase<pg8::EpiResid, pg8::StaticOrder, true, true>(lds, g, S, E, K_TID);
        }
        GSYNC();
        {
            bf16_t* SG = P_Zb;
            pg8::StaticOrder S; S.init(T, DM, G, bx);
            { pg8::Gemm g{P_HB, (const bf16_t*)(AWS + WS_WGT + l * SZ_WGT), T, DM, DM}; pg8::EpiSig E{SG, P_RSQ + (size_t)(2 * l + 1) * T};
              pg8::gemm_phase<pg8::EpiSig, pg8::StaticOrder, true, true>(lds, g, S, E, K_TID);
#ifdef PROBE_SIG2
              pg8::gemm_phase<pg8::EpiSig, pg8::StaticOrder, true, true>(lds, g, S, E, K_TID);
#endif
            }
            GSYNC();
            { int kple = PLED; asm volatile("" : "+s"(kple));
              pg8::Gemm g{P_PB + (size_t)l * T * PLED, (const bf16_t*)(AWS + WS_WPJ + l * SZ_WPJ), T, DM, kple}; pg8::EpiMulAdd E{SG, P_HB, (l == 1) ? AOUT : (float*)nullptr};
              pg8::gemm_phase<pg8::EpiMulAdd, pg8::StaticOrder, true, true>(lds, g, S, E, K_TID); }
        }
        if (l == 0) GSYNC();
    };
    layer(0);
    layer(1);
}

extern "C" void kernel_launch(void* const* d_in, const int* in_sizes, int n_in, void* d_out, int out_size, void* d_ws, size_t ws_size, hipStream_t stream) {
    static int grid_blocks = 0;
    if (!grid_blocks) {
        int dev = 0, cus = 0, per_cu = 0;
        hipGetDevice(&dev);
        hipDeviceGetAttribute(&cus, hipDeviceAttributeMultiprocessorCount, dev);
        hipOccupancyMaxActiveBlocksPerMultiprocessor(&per_cu, fwd_megakernel, 512, 0);
        if (per_cu < 1) per_cu = 1;
        if (cus < 1) cus = 256;
        grid_blocks = cus * 1;
        if (n_in != 18 || ws_size < WS_END) fprintf(stderr, "kernel_launch: unexpected n_in %d or ws_size %zu (< %zu)\n", n_in, ws_size, (size_t)WS_END);
    }
    hipMemsetAsync(d_ws, 0, 16384, stream);
    Args a{};
    for (int i = 0; i < 18; ++i) a.in[i] = (const float*)d_in[i];
    a.out = (float*)d_out; a.ws = (unsigned char*)d_ws;
    void* args[] = {&a};
    hipError_t e = hipLaunchCooperativeKernel((void*)fwd_megakernel, dim3(grid_blocks), dim3(512), args, 0, stream);
    if (e != hipSuccess) fprintf(stderr, "cooperative launch failed: %s (grid %d)\n", hipGetErrorString(e), grid_blocks);
}
```
